# Optimizing an MI355X kernel written in HIP

```python
import jax, jax.numpy as jnp
from jax import lax
import numpy as np

D_MODEL = 1024
BATCH = 4
SEQ = 8192
DEPTH = 2
DEC_BATCH = 128
DEC_SEQ = 1
PAST_LEN = 16384
PAGE_SIZE = 128

CONV_W = D_MODEL
CONV_K = 3
POOL_W = D_MODEL
POOL_WINDOWS = (2, 4, 8, 16)
POOL_GROUPS = len(POOL_WINDOWS)
POOL_GROUP_W = POOL_W // POOL_GROUPS
POOL_MAX = max(POOL_WINDOWS)
HEAD_DIM = 64
N_HEADS = D_MODEL // HEAD_DIM
N_KV_HEADS = 4
GQA_GROUP = N_HEADS // N_KV_HEADS
WINDOW = 128
BLOCK = 128
ROPE_THETA = 10000.0
D_FF = 4 * D_MODEL
RMS_EPS = 1e-6
NEG = -1e30

SPLITS = (CONV_W, CONV_W, CONV_W, POOL_W,
          N_HEADS * HEAD_DIM, N_KV_HEADS * HEAD_DIM, N_KV_HEADS * HEAD_DIM,
          D_MODEL, D_MODEL, D_MODEL)
D_IN_PROJ = sum(SPLITS)
SPLIT_IDX = tuple(sum(SPLITS[:i + 1]) for i in range(len(SPLITS) - 1))

kernel_name = 'hybrid_conv_pool_swa_decoder_step'


def rmsnorm(x, g):
    xf = x.astype(jnp.float32)
    y = xf * lax.rsqrt(jnp.mean(xf * xf, axis=-1, keepdims=True) + RMS_EPS)
    return (y * g.astype(jnp.float32)).astype(x.dtype)


def rope(x, pos):
    half = HEAD_DIM // 2
    inv = ROPE_THETA ** (-jnp.arange(half, dtype=jnp.float32) / half)
    ang = pos.astype(jnp.float32)[:, None] * inv[None, :]
    cos = jnp.cos(ang)[:, None, :]
    sin = jnp.sin(ang)[:, None, :]
    xf = x.astype(jnp.float32)
    x1, x2 = xf[..., :half], xf[..., half:]
    out = jnp.concatenate([x1 * cos - x2 * sin, x2 * cos + x1 * sin], axis=-1)
    return out.astype(x.dtype)


def short_conv(u, past, w):
    T = u.shape[1]
    ext = jnp.concatenate([past, u], axis=1)
    out = w[0] * ext[:, 0:T] + w[1] * ext[:, 1:T + 1] + w[2] * ext[:, 2:T + 2]
    return out, ext[:, T:]


def multiscale_pool(u, past, start):
    T = u.shape[1]
    P = POOL_MAX - 1
    ext = jnp.concatenate([past, u], axis=1)
    cs = jnp.cumsum(ext.astype(jnp.float32), axis=1)
    cs = jnp.pad(cs, ((0, 0), (1, 0), (0, 0)))
    pos = start + jnp.arange(T, dtype=jnp.int32)
    outs = []
    for g, win in enumerate(POOL_WINDOWS):
        lo, hi = g * POOL_GROUP_W, (g + 1) * POOL_GROUP_W
        s = cs[:, P + 1:P + 1 + T, lo:hi] - cs[:, P + 1 - win:P + 1 - win + T, lo:hi]
        cnt = jnp.minimum(win, pos + 1).astype(jnp.float32)[None, :, None]
        outs.append(s / cnt - u[..., lo:hi].astype(jnp.float32))
    pooled = jnp.concatenate(outs, axis=-1).astype(u.dtype)
    return pooled, ext[:, T:]


def window_mask(qpos, kpos):
    d = qpos[..., :, None] - kpos[..., None, :]
    return (d >= 0) & (d < WINDOW) & (kpos[..., None, :] >= 0)


def sink_attend(q, k, v, mask, sinks):
    s = jnp.einsum('...qhgd,...khd->...hgqk', q, k,
                   preferred_element_type=jnp.float32) * (HEAD_DIM ** -0.5)
    s = jnp.where(mask[..., None, None, :, :], s, NEG)
    sk = sinks.astype(jnp.float32).reshape(N_KV_HEADS, GQA_GROUP)[:, :, None, None]
    m = jnp.maximum(jnp.max(s, axis=-1, keepdims=True), sk)
    p = jnp.exp(s - m)
    den = jnp.sum(p, axis=-1, keepdims=True) + jnp.exp(sk - m)
    p = (p / den).astype(v.dtype)
    return jnp.einsum('...hgqk,...khd->...qhgd', p, v)


def swa_banded(q, k, v, sinks):
    B, T = q.shape[:2]
    nb = T // BLOCK
    qb = q.reshape(B, nb, BLOCK, N_KV_HEADS, GQA_GROUP, HEAD_DIM)
    kpad = jnp.pad(k, ((0, 0), (BLOCK, 0), (0, 0), (0, 0)))[:, :T]
    vpad = jnp.pad(v, ((0, 0), (BLOCK, 0), (0, 0), (0, 0)))[:, :T]
    kb = jnp.concatenate([kpad.reshape(B, nb, BLOCK, N_KV_HEADS, HEAD_DIM),
                          k.reshape(B, nb, BLOCK, N_KV_HEADS, HEAD_DIM)], axis=2)
    vb = jnp.concatenate([vpad.reshape(B, nb, BLOCK, N_KV_HEADS, HEAD_DIM),
                          v.reshape(B, nb, BLOCK, N_KV_HEADS, HEAD_DIM)], axis=2)
    qpos = jnp.arange(T, dtype=jnp.int32).reshape(nb, BLOCK)
    kpos = (jnp.arange(nb, dtype=jnp.int32) * BLOCK - BLOCK)[:, None] + jnp.arange(2 * BLOCK, dtype=jnp.int32)[None, :]
    o = sink_attend(qb, kb, vb, window_mask(qpos, kpos), sinks)
    return o.reshape(B, T, N_HEADS * HEAD_DIM)


def swa_with_buffer(q, k, v, k_past, v_past, start, sinks):
    B, T = q.shape[:2]
    sw = k_past.shape[1]
    kc = jnp.concatenate([k_past, k], axis=1)
    vc = jnp.concatenate([v_past, v], axis=1)
    qpos = start + jnp.arange(T, dtype=jnp.int32)
    kpos = start - sw + jnp.arange(sw + T, dtype=jnp.int32)
    o = sink_attend(q.reshape(B, T, N_KV_HEADS, GQA_GROUP, HEAD_DIM), kc, vc,
                    window_mask(qpos, kpos), sinks)
    return o.reshape(B, T, N_HEADS * HEAD_DIM), kc[:, T:], vc[:, T:]


def hybrid_layer(x, conv_past, pool_past, k_past, v_past, start, sw_buf, lp):
    (w_in, conv_w, w_conv_out, w_pool, pool_scale, sinks, w_attn_out, w_mix_out,
     g_pre_mix, g_post_mix, g_pre_mlp, g_post_mlp, w_up, w_down) = lp
    B, T, _ = x.shape
    h = rmsnorm(x, g_pre_mix)
    proj = h @ w_in
    hc, bg, cg, up, q, k, v, gc, gp, ga = jnp.split(proj, SPLIT_IDX, axis=-1)
    conv_out, conv_new = short_conv(cg * hc, conv_past, conv_w)
    y_conv = (bg * conv_out) @ w_conv_out
    pooled, pool_new = multiscale_pool(up, pool_past, start)
    y_pool = jnp.einsum('btgc,gcd->btgd', pooled.reshape(B, T, POOL_GROUPS, POOL_GROUP_W),
                        w_pool).reshape(B, T, POOL_W) * pool_scale
    pos = start + jnp.arange(T, dtype=jnp.int32)
    q = rope(q.reshape(B, T, N_HEADS, HEAD_DIM), pos)
    k = rope(k.reshape(B, T, N_KV_HEADS, HEAD_DIM), pos)
    v = v.reshape(B, T, N_KV_HEADS, HEAD_DIM)
    if k_past is None:
        attn = swa_banded(q, k, v, sinks)
        k_new, v_new = k[:, T - sw_buf:], v[:, T - sw_buf:]
    else:
        attn, k_new, v_new = swa_with_buffer(q, k, v, k_past, v_past, start, sinks)
    y_attn = attn @ w_attn_out
    merged = jax.nn.sigmoid(gc) * y_conv + jax.nn.sigmoid(gp) * y_pool + jax.nn.sigmoid(ga) * y_attn
    x = x + rmsnorm(merged @ w_mix_out, g_post_mix)
    f = jnp.square(jax.nn.relu(rmsnorm(x, g_pre_mlp) @ w_up)) @ w_down
    x = x + rmsnorm(f, g_post_mlp)
    return x, conv_new, pool_new, k_new, v_new


def setup_inputs(seed: int = 0) -> dict:
    key = jax.random.key(seed)
    ks = jax.random.split(key, 22)
    f32 = jnp.float32

    def nrm(k, shape, scale):
        return jax.random.normal(k, shape, f32) * scale

    sw_buf = min(WINDOW, PAST_LEN)
    return {
        'x_prompt': nrm(ks[0], (BATCH, SEQ, D_MODEL), 1.0),
        'x_sample': nrm(ks[1], (DEC_BATCH, DEC_SEQ, D_MODEL), 1.0),
        'state_conv': nrm(ks[2], (DEPTH, DEC_BATCH, CONV_K - 1, CONV_W), 1.0),
        'state_pool': nrm(ks[3], (DEPTH, DEC_BATCH, POOL_MAX - 1, POOL_W), 1.0),
        'cache_k': nrm(ks[4], (DEPTH, DEC_BATCH, sw_buf, N_KV_HEADS, HEAD_DIM), 1.0),
        'cache_v': nrm(ks[5], (DEPTH, DEC_BATCH, sw_buf, N_KV_HEADS, HEAD_DIM), 1.0),
        'w_in': nrm(ks[6], (DEPTH, D_MODEL, D_IN_PROJ), D_MODEL ** -0.5),
        'conv_w': nrm(ks[7], (DEPTH, CONV_K, CONV_W), CONV_K ** -0.5),
        'w_conv_out': nrm(ks[8], (DEPTH, CONV_W, D_MODEL), CONV_W ** -0.5),
        'w_pool': nrm(ks[9], (DEPTH, POOL_GROUPS, POOL_GROUP_W, POOL_GROUP_W), POOL_GROUP_W ** -0.5),
        'pool_scale': 1.0 + nrm(ks[10], (DEPTH, POOL_W), 0.1),
        'attn_sinks': nrm(ks[11], (DEPTH, N_HEADS), 0.5),
        'w_attn_out': nrm(ks[12], (DEPTH, N_HEADS * HEAD_DIM, D_MODEL), (N_HEADS * HEAD_DIM) ** -0.5),
        'w_mix_out': nrm(ks[13], (DEPTH, D_MODEL, D_MODEL), D_MODEL ** -0.5),
        'norm_pre_mix': 1.0 + nrm(ks[14], (DEPTH, D_MODEL), 0.05),
        'norm_post_mix': 1.0 + nrm(ks[15], (DEPTH, D_MODEL), 0.05),
        'norm_pre_mlp': 1.0 + nrm(ks[16], (DEPTH, D_MODEL), 0.05),
        'norm_post_mlp': 1.0 + nrm(ks[17], (DEPTH, D_MODEL), 0.05),
        'w_up': nrm(ks[18], (DEPTH, D_MODEL, D_FF), D_MODEL ** -0.5),
        'w_down': nrm(ks[19], (DEPTH, D_FF, D_MODEL), D_FF ** -0.5),
    }


def reference(x_prompt, x_sample, state_conv, state_pool, cache_k, cache_v,
              w_in, conv_w, w_conv_out, w_pool, pool_scale, attn_sinks, w_attn_out,
              w_mix_out, norm_pre_mix, norm_post_mix, norm_pre_mlp, norm_post_mlp,
              w_up, w_down):
    sw_buf = cache_k.shape[2]
    bp = x_prompt.shape[0]
    xp, xs = x_prompt, x_sample
    pc, pp, pk, pv = [], [], [], []
    sc, sp, sk, sv = [], [], [], []
    for l in range(DEPTH):
        lp = (w_in[l], conv_w[l], w_conv_out[l], w_pool[l], pool_scale[l], attn_sinks[l],
              w_attn_out[l], w_mix_out[l], norm_pre_mix[l], norm_post_mix[l],
              norm_pre_mlp[l], norm_post_mlp[l], w_up[l], w_down[l])
        zc = jnp.zeros((bp, CONV_K - 1, CONV_W), xp.dtype)
        zp = jnp.zeros((bp, POOL_MAX - 1, POOL_W), xp.dtype)
        xp, c_new, p_new, k_new, v_new = hybrid_layer(xp, zc, zp, None, None, 0, sw_buf, lp)
        pc.append(c_new); pp.append(p_new); pk.append(k_new); pv.append(v_new)
        xs, c_new, p_new, k_new, v_new = hybrid_layer(xs, state_conv[l], state_pool[l],
                                                      cache_k[l], cache_v[l], PAST_LEN, sw_buf, lp)
        sc.append(c_new); sp.append(p_new); sk.append(k_new); sv.append(v_new)
    return (xp, xs,
            jnp.stack(pc), jnp.stack(pp), jnp.stack(pk), jnp.stack(pv),
            jnp.stack(sc), jnp.stack(sp), jnp.stack(sk), jnp.stack(sv))
```

```cpp
#include <hip/hip_runtime.h>
#include <hip/hip_cooperative_groups.h>
#include <cstdio>
namespace cg = cooperative_groups;

#define LAS __attribute__((address_space(3)))
typedef unsigned short bf16_t;
typedef short bf16x8 __attribute__((ext_vector_type(8)));
typedef float f32x4 __attribute__((ext_vector_type(4)));
typedef float f32x2 __attribute__((ext_vector_type(2)));
typedef unsigned u32x4 __attribute__((ext_vector_type(4)));
typedef unsigned u32x2 __attribute__((ext_vector_type(2)));

constexpr int DM = 1024, TSEQ = 8192, MPR = 32768, NS = 128, MREAL = MPR + NS, MP = 33024;
constexpr int NPROJ = 8704, DFF = 4096, NMAIN = 5632;
constexpr float RMS_EPS = 1e-6f;
constexpr size_t O_YP = 0, O_YS = O_YP + (size_t)MPR * DM, O_PC = O_YS + (size_t)NS * DM, O_PP = O_PC + 2 * 4 * 2 * 1024,
                 O_PK = O_PP + 2 * 4 * 15 * 1024, O_PV = O_PK + 2 * 4 * 128 * 256, O_SC = O_PV + 2 * 4 * 128 * 256,
                 O_SP = O_SC + 2 * 128 * 2 * 1024, O_SK = O_SP + 2 * 128 * 15 * 1024, O_SV = O_SK + (size_t)2 * 128 * 128 * 256;
constexpr size_t UNIT = (size_t)MP * 1024 * 2;
constexpr size_t WS_ROPE = 4096, ROPE_BYTES = (size_t)8193 * 32 * 8;
constexpr size_t WS_W = WS_ROPE + ((ROPE_BYTES + 4095) / 4096) * 4096;
constexpr size_t WO_IN = 0, WO_CO = WO_IN + (size_t)8704 * 1024, WO_POOL = WO_CO + 1024 * 1024, WO_AO = WO_POOL + 1024 * 256,
                 WO_MIX = WO_AO + 1024 * 1024, WO_UP = WO_MIX + 1024 * 1024, WO_DN = WO_UP + 4096 * 1024, WO_END = WO_DN + 4096 * 1024;
constexpr size_t WS_H = WS_W + ((WO_END * 2 + 4095) / 4096) * 4096;
constexpr size_t WS_R1 = WS_H + UNIT, WS_R2 = WS_R1 + UNIT, WS_R3 = WS_R2 + UNIT, WS_R4 = WS_R3 + UNIT, WS_R5 = WS_R4 + UNIT, WS_GS = WS_R5 + 2 * UNIT, SIDE = (size_t)256 * 1024, WS_MS = WS_GS + 3 * SIDE * 2, WS_MIXP = WS_MS + 3 * SIDE * 2, WS_FP = WS_MIXP + 3 * SIDE * 4, WS_RS = WS_FP + 4 * SIDE * 4, WS_BAR = WS_RS + 2 * (size_t)MP * 4 + 4096 - (2 * (size_t)MP * 4) % 4096, WS_END = WS_BAR + 16384;

struct Params { const float* in[20]; float* out; unsigned char* ws; };
typedef const __attribute__((address_space(4))) Params* PP;

typedef __bf16 bf16v2 __attribute__((ext_vector_type(2)));
__device__ __forceinline__ unsigned cvt_pk_bf16(float lo, float hi) { return __builtin_bit_cast(unsigned, __builtin_convertvector((f32x2){lo, hi}, bf16v2)); }
__device__ __forceinline__ float bf_lo(unsigned w) { return __uint_as_float(w << 16); }
__device__ __forceinline__ float bf_hi(unsigned w) { return __uint_as_float(w & 0xffff0000u); }
__device__ __forceinline__ void unpack8(const u32x4 w, float (&f)[8]) {
    f[0] = bf_lo(w.x); f[1] = bf_hi(w.x); f[2] = bf_lo(w.y); f[3] = bf_hi(w.y); f[4] = bf_lo(w.z); f[5] = bf_hi(w.z); f[6] = bf_lo(w.w); f[7] = bf_hi(w.w); }
__device__ __forceinline__ u32x4 pack8(const float (&f)[8]) { u32x4 w; w.x = cvt_pk_bf16(f[0], f[1]); w.y = cvt_pk_bf16(f[2], f[3]); w.z = cvt_pk_bf16(f[4], f[5]); w.w = cvt_pk_bf16(f[6], f[7]); return w; }
__device__ __forceinline__ float wave_sum(float v) {
#pragma unroll
    for (int o = 32; o >= 1; o >>= 1) v += __shfl_xor(v, o);
    return v; }
__device__ __forceinline__ int opaque_tid() { int t = threadIdx.x; asm volatile("" : "+v"(t)); return t; }
#define OPQ_S(x) asm volatile("" : "+s"(x))
__device__ __forceinline__ float sigmoidf_(float x) { return __builtin_amdgcn_rcpf(1.0f + __expf(-x)); }

__device__ __forceinline__ void st16(void* p, u32x4 v) { *(u32x4*)p = v; }
__device__ __forceinline__ void st16(void* p, f32x4 v) { *(f32x4*)p = v; }
__device__ __forceinline__ void st8(void* p, u32x2 v) { *(u32x2*)p = v; }
__device__ __forceinline__ void st4(void* p, unsigned v) { *(unsigned*)p = v; }

constexpr int BM = 256, BK = 64, HALF = 128, HTB = HALF * BK * 2, STAGE_BYTES = 8 * HTB, NXCD = 8, WGM = 8;
__device__ __forceinline__ int lds_byte(int r, int c) { const int st = (r >> 4) * 2 + (c >> 5), rr = r & 15, cc = c & 31, ob = rr * 64 + cc * 2; return st * 1024 + (ob ^ (((ob >> 9) & 1) << 5)); }
__device__ __forceinline__ void stage_rc(int b, int& R, int& C) { const int st = b / 1024, sb = b % 1024, swz = sb ^ (((sb >> 9) & 1) << 5); R = (st >> 1) * 16 + swz / 64; C = (st & 1) * 32 + (swz % 64) / 2; }
__device__ __forceinline__ int perm32(int rho) { const int n = rho >> 4, i = rho & 15; return 8 * (i >> 2) + 4 * n + (i & 3); }

struct Unit { int pm, pn, tag; const char* a; const char* b; };

struct Extra { int n, per; const char* a0; const char* b0; size_t a_tag_bytes, b_tag_bytes, a_pn_bytes, b_pn_bytes;
    __device__ __forceinline__ bool get(int e, Unit& u) const { if (e >= n) return false; const int tag = e / per, pn = e - tag * per;
        u.pm = 128; u.pn = pn; u.tag = tag; u.a = a0 + (size_t)tag * a_tag_bytes + (size_t)pn * a_pn_bytes; u.b = b0 + (size_t)tag * b_tag_bytes + (size_t)pn * b_pn_bytes; return true; } };
struct PhaseOrder {
    const char* A; const char* Bt; size_t tstepA, tstepB, a_pn_bytes; int nN, nwg, rounds, G, c; Extra X;
    __device__ __forceinline__ void init(const void* A_, const void* Bt_, int lda, int ldb, int a_pn_cols, int nN_, bool prompt) {
        A = (const char*)A_; Bt = (const char*)Bt_; tstepA = (size_t)512 * lda; tstepB = (size_t)512 * ldb; a_pn_bytes = (size_t)a_pn_cols * 2; nN = nN_; nwg = prompt ? 128 * nN_ : 0;
        G = (int)gridDim.x; c = (int)blockIdx.x; rounds = (nwg + G - 1) / G; X = Extra{0, 1, nullptr, nullptr, 0, 0, 0, 0}; }
    __device__ __forceinline__ bool next(int i, Unit& u) const {
        if (i < rounds) { const long L = (long)i * G + c; if (L >= nwg) return false;
            int wgid = (int)L; { const int q = nwg / NXCD, r = nwg % NXCD, xcd = wgid % NXCD, off = wgid / NXCD; wgid = (xcd < r ? xcd * (q + 1) : r * (q + 1) + (xcd - r) * q) + off; }
            const int nig = WGM * nN, gid = wgid / nig, fm = gid * WGM;
            u.pm = fm + ((wgid % nig) % WGM); u.pn = (wgid % nig) / WGM; u.tag = -1; u.a = A + (size_t)u.pm * tstepA + (size_t)u.pn * a_pn_bytes; u.b = Bt + (size_t)u.pn * tstepB; return true; }
        if (i == rounds) return X.get(c, u);
        return false;
    }
};

typedef f32x4 Acc[2][2][4][2];

template <class Epi>
__device__ __forceinline__ void gemm_phase(LAS unsigned char* lds, const int K, const int lda, const int ldb, const PhaseOrder& S, const Epi& E) {
    const int tid = opaque_tid(), wid = __builtin_amdgcn_readfirstlane(tid >> 6), lane = tid & 63, wr = wid >> 2, wc = wid & 3, fr = lane & 15, fq = lane >> 4;
    const int nt = K / BK;
    unsigned voffA[2], voffB[2];
#pragma unroll
    for (int i = 0; i < 2; ++i) { int R, C; stage_rc(tid * 16 + i * 8192, R, C); const int Rb = Epi::PERM ? ((R & ~31) + perm32(R & 31)) : R;
        voffA[i] = (unsigned)(R * lda + C) * 2u; voffB[i] = (unsigned)(Rb * ldb + C) * 2u; }
    const size_t kstep = (size_t)(BK * 2);
    const size_t hstepA = (size_t)HALF * lda * 2, hstepB = (size_t)HALF * ldb * 2;
    const unsigned ldsw = (unsigned)wid * 1024u;
    const int aoff = lds_byte(wr * 64 + fr, fq * 8), boff = lds_byte(wc * 32 + fr, fq * 8);
#define PG8_SA(b, h) (((b) * 2 + (h)) * HTB)
#define PG8_SB(b, h) ((4 + (b) * 2 + (h)) * HTB)
#define PG8_STAGE(bufoff, gbase, voff) do { _Pragma("unroll") for (int _i = 0; _i < 2; ++_i) \
        __builtin_amdgcn_global_load_lds((const unsigned*)((const char*)(gbase) + (voff)[_i]), (LAS unsigned*)(lds + (bufoff) + ldsw + _i * 8192), 16, 0, 0); } while (0)
#define PG8_LDA(dst, b, h) do { _Pragma("unroll") for (int m = 0; m < 4; ++m) _Pragma("unroll") for (int k = 0; k < 2; ++k) dst[m][k] = *(const LAS bf16x8*)(lds + PG8_SA(b, h) + aoff + m * 2048 + k * 1024); } while (0)
#define PG8_LDB(dst, b, h) do { _Pragma("unroll") for (int n = 0; n < 2; ++n) _Pragma("unroll") for (int k = 0; k < 2; ++k) dst[n][k] = *(const LAS bf16x8*)(lds + PG8_SB(b, h) + boff + n * 2048 + k * 1024); } while (0)
#define PG8_MMA(ai, bj, At, Bt) do { __builtin_amdgcn_s_setprio(1); _Pragma("unroll") for (int m = 0; m < 4; ++m) _Pragma("unroll") for (int n = 0; n < 2; ++n) _Pragma("unroll") for (int k = 0; k < 2; ++k) \
        acc[ai][bj][m][n] = __builtin_amdgcn_mfma_f32_16x16x32_bf16(Bt[n][k], At[m][k], acc[ai][bj][m][n], 0, 0, 0); __builtin_amdgcn_s_setprio(0); } while (0)
#define PG8_WAIT_V(n) asm volatile("s_waitcnt vmcnt(" #n ")" ::: "memory")
#define PG8_WAIT_L(n) asm volatile("s_waitcnt lgkmcnt(" #n ")" ::: "memory")
#define PG8_BAR __builtin_amdgcn_s_barrier()
#define PG8_SCHED __builtin_amdgcn_sched_barrier(0)
    Unit cur, nxt; int ui = 0;
    if (!S.next(0, cur)) return;
    Acc acc;
#pragma unroll
    for (int a = 0; a < 2; ++a)
#pragma unroll
        for (int b = 0; b < 2; ++b)
#pragma unroll
            for (int m = 0; m < 4; ++m)
#pragma unroll
                for (int n = 0; n < 2; ++n) acc[a][b][m][n] = (f32x4){0.f, 0.f, 0.f, 0.f};
    bf16x8 At[4][2], B0[2][2], B1[2][2];
    const char* cA = cur.a; const char* cB = cur.b;
    PG8_STAGE(PG8_SB(0, 0), cB, voffB); PG8_STAGE(PG8_SA(0, 0), cA, voffA); PG8_STAGE(PG8_SB(0, 1), cB + hstepB, voffB); PG8_STAGE(PG8_SA(0, 1), cA + hstepA, voffA);
    if (wr == 1) PG8_BAR;
    PG8_WAIT_V(4); PG8_BAR;
    PG8_STAGE(PG8_SB(1, 0), cB + kstep, voffB); PG8_STAGE(PG8_SA(1, 0), cA + kstep, voffA); PG8_STAGE(PG8_SB(1, 1), cB + hstepB + kstep, voffB);
    PG8_WAIT_V(6); PG8_BAR;
    for (;;) {
        const bool has_next = S.next(ui + 1, nxt);
        const char* nA = has_next ? nxt.a : cA; const char* nB = has_next ? nxt.b : cB;
        for (int t = 0; t < nt; t += 2) {
            const bool last = (t == nt - 2);
            const char* a1 = cA + (size_t)(t + 1) * kstep;
            const char* a2 = last ? nA : cA + (size_t)(t + 2) * kstep; const char* b2 = last ? nB : cB + (size_t)(t + 2) * kstep;
            const char* a3 = a2 + kstep; const char* b3 = b2 + kstep;
            PG8_LDB(B0, 0, 0); PG8_SCHED; PG8_LDA(At, 0, 0); PG8_STAGE(PG8_SA(1, 1), a1 + hstepA, voffA);
            PG8_WAIT_L(8); PG8_BAR; PG8_WAIT_L(0); PG8_MMA(0, 0, At, B0); PG8_BAR; PG8_SCHED;
            PG8_LDB(B1, 0, 1); PG8_STAGE(PG8_SB(0, 0), b2, voffB);
            PG8_BAR; PG8_WAIT_L(0); PG8_MMA(0, 1, At, B1); PG8_BAR;
            PG8_LDA(At, 0, 1); PG8_STAGE(PG8_SA(0, 0), a2, voffA);
            PG8_BAR; PG8_WAIT_L(0); PG8_MMA(1, 0, At, B0); PG8_BAR; PG8_SCHED;
            PG8_STAGE(PG8_SB(0, 1), b2 + hstepB, voffB);
            PG8_WAIT_V(6); PG8_BAR; PG8_MMA(1, 1, At, B1); PG8_BAR;
            PG8_LDB(B0, 1, 0); PG8_SCHED; PG8_LDA(At, 1, 0); PG8_STAGE(PG8_SA(0, 1), a2 + hstepA, voffA);
            PG8_WAIT_L(8); PG8_BAR; PG8_WAIT_L(0); PG8_MMA(0, 0, At, B0); PG8_BAR; PG8_SCHED;
            PG8_LDB(B1, 1, 1); PG8_STAGE(PG8_SB(1, 0), b3, voffB);
            PG8_BAR; PG8_WAIT_L(0); PG8_MMA(0, 1, At, B1); PG8_BAR;
            PG8_LDA(At, 1, 1); PG8_STAGE(PG8_SA(1, 0), a3, voffA);
            PG8_BAR; PG8_WAIT_L(0); PG8_MMA(1, 0, At, B0); PG8_BAR; PG8_SCHED;
            PG8_STAGE(PG8_SB(1, 1), b3 + hstepB, voffB);
            PG8_WAIT_V(6); PG8_BAR; PG8_MMA(1, 1, At, B1); PG8_BAR;
        }
        E(acc, cur, wr, wc, fr, fq);
        if (!has_next) break;
#pragma unroll
        for (int a = 0; a < 2; ++a)
#pragma unroll
            for (int b = 0; b < 2; ++b)
#pragma unroll
                for (int m = 0; m < 4; ++m)
#pragma unroll
                    for (int n = 0; n < 2; ++n) acc[a][b][m][n] = (f32x4){0.f, 0.f, 0.f, 0.f};
        cur = nxt; cA = nA; cB = nB; ++ui;
    }
    PG8_WAIT_V(0);
    if (wr == 0) PG8_BAR;
    PG8_BAR;
#undef PG8_SA
#undef PG8_SB
#undef PG8_STAGE
#undef PG8_LDA
#undef PG8_LDB
#undef PG8_MMA
#undef PG8_WAIT_V
#undef PG8_WAIT_L
#undef PG8_BAR
#undef PG8_SCHED
}

__device__ __forceinline__ u32x4 pk2x4(const f32x4 v0, const f32x4 v1) { u32x4 w; w.x = cvt_pk_bf16(v0[0], v0[1]); w.y = cvt_pk_bf16(v0[2], v0[3]); w.z = cvt_pk_bf16(v1[0], v1[1]); w.w = cvt_pk_bf16(v1[2], v1[3]); return w; }

struct EpiMain {
    static constexpr bool PERM = true;
    bf16_t *Ub, *BGb, *UPb, *Qb, *Kb, *Vb; const f32x4* rope; bf16_t* GS; const float* RS;
    __device__ __forceinline__ void operator()(const Acc& acc, const Unit& u, int wr, int wc, int fr, int fq) const {
        const int row0 = u.pm * BM + wr * 64 + fr, pn = u.pn;
        float rs[2][4];
#pragma unroll
        for (int ai = 0; ai < 2; ++ai)
#pragma unroll
            for (int m = 0; m < 4; ++m) rs[ai][m] = RS[row0 + ai * HALF + m * 16];
        if (pn < 8) {
#pragma unroll
            for (int ai = 0; ai < 2; ++ai)
#pragma unroll
                for (int m = 0; m < 4; ++m) { const size_t row = row0 + ai * HALF + m * 16;
                    st16(Ub + row * 1024 + pn * 128 + wc * 32 + fq * 8, pk2x4(acc[ai][0][m][0] * acc[ai][1][m][0] * (rs[ai][m] * rs[ai][m]), acc[ai][0][m][1] * acc[ai][1][m][1] * (rs[ai][m] * rs[ai][m]))); __builtin_amdgcn_sched_barrier(0); }
        } else if (pn < 16) {
            bf16_t* base = (pn < 12 ? BGb : UPb) + (pn & 3) * 256 + wc * 32 + fq * 8;
#pragma unroll
            for (int ai = 0; ai < 2; ++ai)
#pragma unroll
                for (int m = 0; m < 4; ++m) { const size_t row = row0 + ai * HALF + m * 16;
#pragma unroll
                    for (int bj = 0; bj < 2; ++bj) st16(base + row * 1024 + bj * HALF, pk2x4(acc[ai][bj][m][0] * rs[ai][m], acc[ai][bj][m][1] * rs[ai][m])); __builtin_amdgcn_sched_barrier(0); }
        } else if (pn < 21) {
            const bool isq = pn < 20; const int ld = isq ? 1024 : 256; const float sc = isq ? 0.125f * 1.4426950408889634f : 1.0f;
            bf16_t* base = (isq ? Qb + (pn - 16) * 256 : Kb) + wc * 64 + fq * 8;
#pragma unroll
            for (int am = 0; am < 4; ++am) { const int ai = am >> 1, mh = (am & 1) * 2;
                f32x4 cs[2][4];
#pragma unroll
                for (int mm = 0; mm < 2; ++mm) { const int row = row0 + ai * HALF + (mh + mm) * 16; const int pos = row < MPR ? (row & (TSEQ - 1)) : TSEQ;
                    const f32x4* rp = rope + (size_t)pos * 16 + fq * 4;
#pragma unroll
                    for (int q = 0; q < 4; ++q) cs[mm][q] = rp[q]; }
                __builtin_amdgcn_sched_barrier(0);
#pragma unroll
                for (int mm = 0; mm < 2; ++mm) { const int m = mh + mm; const int row = row0 + ai * HALF + m * 16;
                    f32x4 o1[2], o2[2];
#pragma unroll
                    for (int n = 0; n < 2; ++n) { const f32x4 cs0 = cs[mm][2 * n], cs1 = cs[mm][2 * n + 1]; const f32x4 x1 = acc[ai][0][m][n], x2 = acc[ai][1][m][n];
                        const float scr = sc * rs[ai][m]; const f32x4 c = (f32x4){cs0[0], cs0[2], cs1[0], cs1[2]} * scr, s = (f32x4){cs0[1], cs0[3], cs1[1], cs1[3]} * scr;
                        o1[n] = x1 * c - x2 * s; o2[n] = x2 * c + x1 * s; }
                    st16(base + (size_t)row * ld, pk2x4(o1[0], o1[1])); st16(base + (size_t)row * ld + 32, pk2x4(o2[0], o2[1])); __builtin_amdgcn_sched_barrier(0); }
            }
        } else if (pn == 21) {
            bf16_t* base = Vb + wc * 32 + fq * 8;
#pragma unroll
            for (int ai = 0; ai < 2; ++ai)
#pragma unroll
                for (int m = 0; m < 4; ++m) { const size_t row = row0 + ai * HALF + m * 16;
#pragma unroll
                    for (int bj = 0; bj < 2; ++bj) st16(base + row * 256 + bj * HALF, pk2x4(acc[ai][bj][m][0] * rs[ai][m], acc[ai][bj][m][1] * rs[ai][m])); __builtin_amdgcn_sched_barrier(0); }
        } else {
            const int gi = (pn - 22) >> 2; bf16_t* base = GS + (size_t)gi * SIDE + ((pn - 22) & 3) * 256 + wc * 32 + fq * 8;
#pragma unroll
            for (int ai = 0; ai < 2; ++ai)
#pragma unroll
                for (int m = 0; m < 4; ++m) { const size_t rl = (size_t)(row0 - MPR + ai * HALF + m * 16);
#pragma unroll
                    for (int bj = 0; bj < 2; ++bj) { f32x4 v0 = acc[ai][bj][m][0], v1 = acc[ai][bj][m][1];
#pragma unroll
                        for (int j = 0; j < 4; ++j) { v0[j] = sigmoidf_(v0[j] * rs[ai][m]); v1[j] = sigmoidf_(v1[j] * rs[ai][m]); }
                        st16(base + rl * 1024 + bj * HALF, pk2x4(v0, v1)); } __builtin_amdgcn_sched_barrier(0); }
        }
    }
};
template <int ACT> struct EpiAct {
    static constexpr bool PERM = true;
    bf16_t* O; int ldc; const float* RS;
    __device__ __forceinline__ void operator()(const Acc& acc, const Unit& u, int wr, int wc, int fr, int fq) const {
        const int row0 = u.pm * BM + wr * 64 + fr; bf16_t* base = O + u.pn * BM + wc * 32 + fq * 8;
        float rsv[2][4];
#pragma unroll
        for (int ai = 0; ai < 2; ++ai)
#pragma unroll
            for (int m = 0; m < 4; ++m) rsv[ai][m] = RS[row0 + ai * HALF + m * 16];
#pragma unroll
        for (int ai = 0; ai < 2; ++ai)
#pragma unroll
            for (int m = 0; m < 4; ++m) { const size_t row = row0 + ai * HALF + m * 16; const float rs = rsv[ai][m];
#pragma unroll
                for (int bj = 0; bj < 2; ++bj) { f32x4 v0 = acc[ai][bj][m][0], v1 = acc[ai][bj][m][1];
#pragma unroll
                    for (int j = 0; j < 4; ++j) { if (ACT == 0) { v0[j] = sigmoidf_(v0[j] * rs); v1[j] = sigmoidf_(v1[j] * rs); } else { const float a = fmaxf(v0[j] * rs, 0.f), b = fmaxf(v1[j] * rs, 0.f); v0[j] = a * a; v1[j] = b * b; } }
                    st16(base + row * ldc + bj * HALF, pk2x4(v0, v1)); __builtin_amdgcn_sched_barrier(0); } }
    }
};
struct EpiGate {
    static constexpr bool PERM = true;
    bf16_t* MG; const bf16_t* SG; bool accum; const bf16_t* GS; bf16_t* MS; int g0, g1;
    __device__ __forceinline__ void operator()(const Acc& acc, const Unit& u, int wr, int wc, int fr, int fq) const {
        const bool smp = u.tag >= 0; const int gi = u.tag == 0 ? g0 : g1;
        const int row0 = (smp ? 0 : u.pm * BM) + wr * 64 + fr, col0 = u.pn * BM + wc * 32 + fq * 8;
        const bf16_t* sgb = smp ? GS + (size_t)gi * SIDE : SG; bf16_t* mgb = smp ? MS + (size_t)gi * SIDE : MG; const bool acc_on = accum && !smp;
#pragma unroll
        for (int ai = 0; ai < 2; ++ai) {
            u32x4 sgv[4][2], mgv[4][2];
#pragma unroll
            for (int m = 0; m < 4; ++m)
#pragma unroll
                for (int bj = 0; bj < 2; ++bj) { const size_t off = (size_t)(row0 + ai * HALF + m * 16) * 1024 + col0 + bj * HALF;
                    sgv[m][bj] = *(const u32x4*)(sgb + off); mgv[m][bj] = acc_on ? *(const u32x4*)(mgb + off) : (u32x4){0u, 0u, 0u, 0u}; }
            __builtin_amdgcn_sched_barrier(0);
#pragma unroll
            for (int m = 0; m < 4; ++m) {
#pragma unroll
                for (int bj = 0; bj < 2; ++bj) { const size_t off = (size_t)(row0 + ai * HALF + m * 16) * 1024 + col0 + bj * HALF;
                    float sg[8], mg[8]; unpack8(sgv[m][bj], sg); unpack8(mgv[m][bj], mg);
                    const f32x4 a0 = acc[ai][bj][m][0], a1 = acc[ai][bj][m][1];
#pragma unroll
                    for (int j = 0; j < 4; ++j) { mg[j] += sg[j] * a0[j]; mg[4 + j] += sg[4 + j] * a1[j]; }
                    st16(mgb + off, pack8(mg)); }
                __builtin_amdgcn_sched_barrier(0); }
        }
    }
};
struct EpiOut {
    static constexpr bool PERM = true;
    bf16_t* C; float* CS;
    __device__ __forceinline__ void operator()(const Acc& acc, const Unit& u, int wr, int wc, int fr, int fq) const {
        const bool smp = u.tag >= 0;
        const int row0 = (smp ? 0 : u.pm * BM) + wr * 64 + fr, col0 = u.pn * BM + wc * 32 + 8 * fq;
        if (!smp) {
#pragma unroll
            for (int ai = 0; ai < 2; ++ai)
#pragma unroll
                for (int m = 0; m < 4; ++m) { bf16_t* rowp = C + (size_t)(row0 + ai * HALF + m * 16) * 1024 + col0;
#pragma unroll
                    for (int bj = 0; bj < 2; ++bj) st16(rowp + bj * HALF, pk2x4(acc[ai][bj][m][0], acc[ai][bj][m][1])); __builtin_amdgcn_sched_barrier(0); }
        } else { float* cb = CS + (size_t)u.tag * SIDE;
#pragma unroll
            for (int ai = 0; ai < 2; ++ai)
#pragma unroll
                for (int m = 0; m < 4; ++m) { float* rowp = cb + (size_t)(row0 + ai * HALF + m * 16) * 1024 + col0;
#pragma unroll
                    for (int bj = 0; bj < 2; ++bj)
#pragma unroll
                        for (int n = 0; n < 2; ++n) st16(rowp + bj * HALF + n * 4, acc[ai][bj][m][n]); __builtin_amdgcn_sched_barrier(0); }
        }
    }
};

struct EpiF32 {
    static constexpr bool PERM = false;
    float* C; float* CS;
    __device__ __forceinline__ void operator()(const Acc& acc, const Unit& u, int wr, int wc, int fr, int fq) const {
        const bool smp = u.tag >= 0;
        const int row0 = (smp ? 0 : u.pm * BM) + wr * 64 + fr, col0 = u.pn * BM + wc * 32 + 4 * fq;
        float* cb = smp ? CS + (size_t)u.tag * SIDE : C;
#pragma unroll
        for (int ai = 0; ai < 2; ++ai)
#pragma unroll
            for (int m = 0; m < 4; ++m) { float* rowp = cb + (size_t)(row0 + ai * HALF + m * 16) * 1024 + col0;
#pragma unroll
                for (int bj = 0; bj < 2; ++bj)
#pragma unroll
                    for (int n = 0; n < 2; ++n) st16(rowp + bj * HALF + n * 16, acc[ai][bj][m][n]); __builtin_amdgcn_sched_barrier(0); }
    }
};

__device__ __forceinline__ int win_src_col(int n) {
    const int pn = n >> 8, w = n & 255;
    if (pn < 8) return ((w >> 7) ? 2048 : 0) + pn * 128 + (w & 127);
    if (pn < 12) return 1024 + (pn - 8) * 256 + w;
    if (pn < 16) return n;
    if (pn < 21) { const int base = pn < 20 ? 4096 + (pn - 16) * 256 : 5120; return base + ((w & 127) >> 5) * 64 + (w >> 7) * 32 + (w & 31); }
    return n;
}
__device__ __forceinline__ void convert_job(LAS unsigned char* lds, const float* src, int ld, int K, int N, bf16_t* dst, bool mapped, int& cum, const float* cscale = nullptr, int wg_first = 0, const float* kscale = nullptr) {
    const int tid = opaque_tid(), G = (int)gridDim.x - wg_first, c = (int)blockIdx.x - wg_first;
    const int nkb = K / 128, ntiles = (N / 32) * nkb;
    const int first = (c + G - (cum % G)) % G; cum += ntiles;
    LAS bf16_t* tile = (LAS bf16_t*)lds;
    const int c4 = tid & 7, kr = tid >> 3;
    f32x4 v[2]; f32x4 cs = (f32x4){1.f, 1.f, 1.f, 1.f};
    if (first < ntiles) { const int nb = first / nkb, kb = first % nkb, n0 = nb * 32, k0 = kb * 128; const int sc0 = mapped ? win_src_col(n0) : n0;
#pragma unroll
        for (int i = 0; i < 2; ++i) v[i] = *(const f32x4*)(src + (size_t)(k0 + kr + 64 * i) * ld + sc0 + 4 * c4);
        if (cscale) cs = *(const f32x4*)(cscale + sc0 + 4 * c4); }
    for (int ti = first; ti < ntiles; ti += G) {
        const int nb = ti / nkb, kb = ti % nkb, n0 = nb * 32, k0 = kb * 128;
        __syncthreads();
#pragma unroll
        for (int i = 0; i < 2; ++i) { const int kk = kr + 64 * i; const f32x4 w = v[i] * cs * (kscale ? kscale[k0 + kk] : 1.0f); const unsigned p0 = cvt_pk_bf16(w[0], w[1]), p1 = cvt_pk_bf16(w[2], w[3]);
            tile[(4 * c4 + 0) * 136 + kk] = (bf16_t)(p0 & 0xffff); tile[(4 * c4 + 1) * 136 + kk] = (bf16_t)(p0 >> 16);
            tile[(4 * c4 + 2) * 136 + kk] = (bf16_t)(p1 & 0xffff); tile[(4 * c4 + 3) * 136 + kk] = (bf16_t)(p1 >> 16); }
        __syncthreads();
        const int tn = ti + G;
        if (tn < ntiles) { const int nb2 = tn / nkb, kb2 = tn % nkb, n02 = nb2 * 32, k02 = kb2 * 128; const int sc2 = mapped ? win_src_col(n02) : n02;
#pragma unroll
            for (int i = 0; i < 2; ++i) v[i] = *(const f32x4*)(src + (size_t)(k02 + kr + 64 * i) * ld + sc2 + 4 * c4);
            if (cscale) cs = *(const f32x4*)(cscale + sc2 + 4 * c4); }
        const int n = tid >> 4, kk = (tid & 15) * 8;
        *(u32x4*)(dst + (size_t)(n0 + n) * K + k0 + kk) = *(const LAS u32x4*)(tile + n * 136 + kk);
    }
}
__device__ __forceinline__ void convert_layer(LAS unsigned char* lds, PP p, int l, int parts = 3, int wg_first = 0) {
    if ((int)blockIdx.x < wg_first) return;
    unsigned char* ws = p->ws; OPQ_S(ws); bf16_t* W = (bf16_t*)(ws + WS_W); int cum = 0;
    if (parts & 1) {
        convert_job(lds, p->in[6] + (size_t)l * 1024 * NPROJ, NPROJ, 1024, NPROJ, W + WO_IN, true, cum, nullptr, wg_first, p->in[14] + l * 1024);
        convert_job(lds, p->in[8] + (size_t)l * 1024 * 1024, 1024, 1024, 1024, W + WO_CO, false, cum, nullptr, wg_first);
        for (int g = 0; g < 4; ++g) convert_job(lds, p->in[9] + (size_t)l * 262144 + g * 65536, 256, 256, 256, W + WO_POOL + g * 65536, false, cum, p->in[10] + l * 1024 + g * 256, wg_first);
        convert_job(lds, p->in[12] + (size_t)l * 1024 * 1024, 1024, 1024, 1024, W + WO_AO, false, cum, nullptr, wg_first);
        convert_job(lds, p->in[13] + (size_t)l * 1024 * 1024, 1024, 1024, 1024, W + WO_MIX, false, cum, nullptr, wg_first);
    }
    if (parts & 2) {
        convert_job(lds, p->in[18] + (size_t)l * 1024 * DFF, DFF, 1024, DFF, W + WO_UP, false, cum, nullptr, wg_first, p->in[16] + l * 1024);
        convert_job(lds, p->in[19] + (size_t)l * DFF * 1024, 1024, DFF, 1024, W + WO_DN, false, cum, nullptr, wg_first);
    }
}

__device__ __forceinline__ void row_phase(const float* xin_p, const float* xin_s, const bf16_t* xin_b, float* xout_p, float* xout_s, bf16_t* xout_b, const bf16_t* Y, const float* g_post,
                                          float* RSout, const float* Ypart, int nparts, int r_lo, int r_hi, int wg_first) {
    const int tid_ = opaque_tid(); const int lane = tid_ & 63, wid = tid_ >> 6;
    constexpr int RPW = 4;
    if ((int)blockIdx.x < wg_first) return;
    for (int row0 = r_lo + (((int)blockIdx.x - wg_first) * 8 + wid) * RPW; row0 < r_hi; row0 += ((int)gridDim.x - wg_first) * 8 * RPW) {
        f32x4 x[RPW][4], y[RPW][4];
#pragma unroll
        for (int j = 0; j < RPW; ++j) { const int row = row0 + j;
            if (xin_b) {
#pragma unroll
                for (int i = 0; i < 4; ++i) { const u32x2 w = *(const u32x2*)(xin_b + (size_t)row * 1024 + i * 256 + lane * 4); x[j][i] = (f32x4){bf_lo(w.x), bf_hi(w.x), bf_lo(w.y), bf_hi(w.y)}; }
            } else { const float* xi = row < MPR ? xin_p + (size_t)row * 1024 : xin_s + (size_t)(row - MPR) * 1024;
#pragma unroll
                for (int i = 0; i < 4; ++i) x[j][i] = *(const f32x4*)(xi + i * 256 + lane * 4); } }
        if (Y) {
#pragma unroll
            for (int j = 0; j < RPW; ++j)
#pragma unroll
                for (int i = 0; i < 4; ++i) { const u32x2 w = *(const u32x2*)(Y + (size_t)(row0 + j) * 1024 + i * 256 + lane * 4); y[j][i] = (f32x4){bf_lo(w.x), bf_hi(w.x), bf_lo(w.y), bf_hi(w.y)}; }
            if (row0 >= MPR && Ypart) {
#pragma unroll
                for (int j = 0; j < RPW; ++j)
#pragma unroll
                    for (int i = 0; i < 4; ++i) y[j][i] = *(const f32x4*)(Ypart + (size_t)(row0 - MPR + j) * 1024 + i * 256 + lane * 4);
                for (int k = 1; k < nparts; ++k)
#pragma unroll
                    for (int j = 0; j < RPW; ++j)
#pragma unroll
                        for (int i = 0; i < 4; ++i) y[j][i] += *(const f32x4*)(Ypart + (size_t)k * SIDE + (size_t)(row0 - MPR + j) * 1024 + i * 256 + lane * 4);
            }
            f32x4 g[4];
#pragma unroll
            for (int i = 0; i < 4; ++i) g[i] = *(const f32x4*)(g_post + i * 256 + lane * 4);
#pragma unroll
            for (int j = 0; j < RPW; ++j) { float ss = 0.f;
#pragma unroll
                for (int i = 0; i < 4; ++i) ss += y[j][i][0] * y[j][i][0] + y[j][i][1] * y[j][i][1] + y[j][i][2] * y[j][i][2] + y[j][i][3] * y[j][i][3];
                ss = wave_sum(ss); const float rstd = rsqrtf(ss * (1.0f / 1024.0f) + RMS_EPS);
#pragma unroll
                for (int i = 0; i < 4; ++i) x[j][i] += y[j][i] * rstd * g[i]; }
        }
#pragma unroll
        for (int j = 0; j < RPW; ++j) { const int row = row0 + j;
            if (xout_b) {
#pragma unroll
                for (int i = 0; i < 4; ++i) { u32x2 w; w.x = cvt_pk_bf16(x[j][i][0], x[j][i][1]); w.y = cvt_pk_bf16(x[j][i][2], x[j][i][3]);
                    st8(xout_b + (size_t)row * 1024 + i * 256 + lane * 4, w);
                    x[j][i] = (f32x4){bf_lo(w.x), bf_hi(w.x), bf_lo(w.y), bf_hi(w.y)}; }
            } else if (xout_p) { float* xo = row < MPR ? xout_p + (size_t)row * 1024 : xout_s + (size_t)(row - MPR) * 1024;
#pragma unroll
                for (int i = 0; i < 4; ++i) *(f32x4*)(xo + i * 256 + lane * 4) = x[j][i]; }
            if (RSout) { float ss = 0.f;
#pragma unroll
                for (int i = 0; i < 4; ++i) ss += x[j][i][0] * x[j][i][0] + x[j][i][1] * x[j][i][1] + x[j][i][2] * x[j][i][2] + x[j][i][3] * x[j][i][3];
                ss = wave_sum(ss); if (lane == 0) RSout[row] = rsqrtf(ss * (1.0f / 1024.0f) + RMS_EPS); }
        }
    }
}

__device__ __forceinline__ void rope_table(f32x2* tab) {
    for (int i = blockIdx.x * 512 + opaque_tid(); i < 8193 * 32; i += gridDim.x * 512) {
        const int pos = i >> 5, d = i & 31; const float fpos = pos == 8192 ? 16384.0f : (float)pos;
        const float inv = powf(10000.0f, -(float)d / 32.0f); const float ang = fpos * inv;
        float s, c; sincosf(ang, &s, &c); tab[i] = (f32x2){c, s};
    }
}

struct AttnKV { u32x4 k[4]; u32x4 va[2], vb[2]; bf16x8 q[2][2]; };
__device__ __forceinline__ void attn_load_kv(int tid, int item, const bf16_t* Kb, const bf16_t* Vb, const bf16_t* Qb, AttnKV& r) {
    const int kvh = item & 3, qb = (item >> 2) & 63, b = item >> 8; const int rb = b * TSEQ + qb * 128;
    { const int wid = tid >> 6, lane = tid & 63, fr = lane & 15, fq = lane >> 4, hl = wid >> 1, half = wid & 1, head = kvh * 4 + hl;
#pragma unroll
      for (int qt = 0; qt < 2; ++qt) { const bf16_t* qrow = Qb + (size_t)(rb + half * 64 + qt * 16 + fr) * 1024 + head * 64 + fq * 8; r.q[qt][0] = *(const bf16x8*)qrow; r.q[qt][1] = *(const bf16x8*)(qrow + 32); } }
#pragma unroll
    for (int i = 0; i < 4; ++i) { const int id = tid + 512 * i, j = id >> 3, c8 = id & 7; const long tok = (long)rb - 128 + j;
        r.k[i] = (qb > 0 || j >= 128) ? *(const u32x4*)(Kb + tok * 256 + kvh * 64 + c8 * 8) : (u32x4){0u, 0u, 0u, 0u}; }
#pragma unroll
    for (int i = 0; i < 2; ++i) { const int id = tid + 512 * i, jp = id >> 3, c8 = id & 7; const long tok = (long)rb - 128 + 2 * jp;
        if (qb > 0 || jp >= 64) { r.va[i] = *(const u32x4*)(Vb + tok * 256 + kvh * 64 + c8 * 8); r.vb[i] = *(const u32x4*)(Vb + (tok + 1) * 256 + kvh * 64 + c8 * 8); }
        else { r.va[i] = (u32x4){0u, 0u, 0u, 0u}; r.vb[i] = (u32x4){0u, 0u, 0u, 0u}; } }
}
__device__ __forceinline__ void attn_store_kv(LAS unsigned char* lds, int tid, const AttnKV& r) {
    LAS bf16_t* Ks = (LAS bf16_t*)lds;
    LAS bf16_t* Vt = (LAS bf16_t*)(lds + 36864);
#pragma unroll
    for (int i = 0; i < 4; ++i) { const int id = tid + 512 * i, j = id >> 3, c8 = id & 7; *(LAS u32x4*)(Ks + j * 72 + c8 * 8) = r.k[i]; }
#pragma unroll
    for (int i = 0; i < 2; ++i) { const int id = tid + 512 * i, jp = id >> 3, c8 = id & 7; LAS unsigned* vp = (LAS unsigned*)(Vt + (c8 * 8) * 264 + 2 * jp);
        const u32x4 a = r.va[i], bq = r.vb[i];
        vp[0 * 132] = (a.x & 0xffffu) | (bq.x << 16); vp[1 * 132] = (a.x >> 16) | (bq.x & 0xffff0000u);
        vp[2 * 132] = (a.y & 0xffffu) | (bq.y << 16); vp[3 * 132] = (a.y >> 16) | (bq.y & 0xffff0000u);
        vp[4 * 132] = (a.z & 0xffffu) | (bq.z << 16); vp[5 * 132] = (a.z >> 16) | (bq.z & 0xffff0000u);
        vp[6 * 132] = (a.w & 0xffffu) | (bq.w << 16); vp[7 * 132] = (a.w >> 16) | (bq.w & 0xffff0000u); }
}
__device__ __forceinline__ void attn_prompt_compute(LAS unsigned char* lds, int item, bf16_t* Qb, const bf16x8 (&q01)[2][2], const float* sinks, bf16_t* Ob) {
    const int tid = opaque_tid(), wid = tid >> 6, lane = tid & 63, fr = lane & 15, fq = lane >> 4;
    const int kvh = item & 3, qb = (item >> 2) & 63, b = item >> 8;
    const int rb = b * TSEQ + qb * 128;
    LAS bf16_t* Ks = (LAS bf16_t*)lds;
    LAS bf16_t* Vt = (LAS bf16_t*)(lds + 36864);
    const int hl = wid >> 1, half = wid & 1, head = kvh * 4 + hl;
    const float sink = sinks[head] * 1.4426950408889634f;
    bf16x8 qf[4][2];
    qf[0][0] = q01[0][0]; qf[0][1] = q01[0][1]; qf[1][0] = q01[1][0]; qf[1][1] = q01[1][1];
#pragma unroll
    for (int qt = 2; qt < 4; ++qt) { const bf16_t* qrow = Qb + (size_t)(rb + half * 64 + qt * 16 + fr) * 1024 + head * 64 + fq * 8; qf[qt][0] = *(const bf16x8*)qrow; qf[qt][1] = *(const bf16x8*)(qrow + 32); }
#pragma unroll
    for (int qp = 0; qp < 2; ++qp) {
        const int i0p = half * 64 + qp * 32;
        const int js = min(i0p, 96);
        f32x4 S[2][10];
        __builtin_amdgcn_s_setprio(1);
#pragma unroll
        for (int kt = 0; kt < 10; ++kt) {
            const LAS bf16_t* kp = Ks + (js + kt * 16 + fr) * 72 + fq * 8;
            const bf16x8 k0 = *(const LAS bf16x8*)kp, k1 = *(const LAS bf16x8*)(kp + 32);
#pragma unroll
            for (int u = 0; u < 2; ++u) { f32x4 sv = (f32x4){0.f, 0.f, 0.f, 0.f};
                sv = __builtin_amdgcn_mfma_f32_16x16x32_bf16(k0, qf[2 * qp + u][0], sv, 0, 0, 0);
                sv = __builtin_amdgcn_mfma_f32_16x16x32_bf16(k1, qf[2 * qp + u][1], sv, 0, 0, 0);
                S[u][kt] = sv; }
        }
        __builtin_amdgcn_s_setprio(0);
        float mx[2], rden[2];
#pragma unroll
        for (int u = 0; u < 2; ++u) { const int i0 = i0p + 16 * u, iq = i0 + fr; float m = -1e30f;
#pragma unroll
            for (int kt = 0; kt < 10; ++kt) { const int jb = js + kt * 16;
                const bool interior = (jb >= i0 + 16) && (jb <= i0 + 113) && (qb > 0 || jb >= 128);
                if (interior) {
#pragma unroll
                    for (int r = 0; r < 4; ++r) m = fmaxf(m, S[u][kt][r]);
                } else {
#pragma unroll
                    for (int r = 0; r < 4; ++r) { const int j = jb + fq * 4 + r; const int dlt = j - iq;
                        const bool ok = (dlt >= 1) && (dlt <= 128) && (qb > 0 || j >= 128);
                        const float v = ok ? S[u][kt][r] : -1e30f; S[u][kt][r] = v; m = fmaxf(m, v); } } }
            mx[u] = m; }
#pragma unroll
        for (int u = 0; u < 2; ++u) { float m = mx[u]; m = fmaxf(m, __shfl_xor(m, 16)); m = fmaxf(m, __shfl_xor(m, 32)); mx[u] = fmaxf(m, sink); }
#pragma unroll
        for (int u = 0; u < 2; ++u) { float sum = 0.f;
#pragma unroll
            for (int kt = 0; kt < 10; ++kt)
#pragma unroll
                for (int r = 0; r < 4; ++r) { const float e = __builtin_amdgcn_exp2f(S[u][kt][r] - mx[u]); S[u][kt][r] = e; sum += e; }
            rden[u] = sum; }
#pragma unroll
        for (int u = 0; u < 2; ++u) { float sum = rden[u]; sum += __shfl_xor(sum, 16); sum += __shfl_xor(sum, 32); rden[u] = 1.0f / (sum + __builtin_amdgcn_exp2f(sink - mx[u])); }
        f32x4 O[2][4];
#pragma unroll
        for (int u = 0; u < 2; ++u)
#pragma unroll
            for (int dt = 0; dt < 4; ++dt) O[u][dt] = (f32x4){0.f, 0.f, 0.f, 0.f};
        __builtin_amdgcn_s_setprio(1);
#pragma unroll
        for (int kp = 0; kp < 5; ++kp) {
            bf16x8 pf[2];
#pragma unroll
            for (int u = 0; u < 2; ++u) { u32x4 pw; pw.x = cvt_pk_bf16(S[u][2 * kp][0], S[u][2 * kp][1]); pw.y = cvt_pk_bf16(S[u][2 * kp][2], S[u][2 * kp][3]);
                pw.z = cvt_pk_bf16(S[u][2 * kp + 1][0], S[u][2 * kp + 1][1]); pw.w = cvt_pk_bf16(S[u][2 * kp + 1][2], S[u][2 * kp + 1][3]); pf[u] = __builtin_bit_cast(bf16x8, pw); }
            const int jb0 = js + 32 * kp;
#pragma unroll
            for (int dt = 0; dt < 4; ++dt) {
                const LAS bf16_t* vp = Vt + (dt * 16 + fr) * 264 + jb0 + 4 * fq;
                const u32x2 v0 = *(const LAS u32x2*)vp, v1 = *(const LAS u32x2*)(vp + 16);
                const bf16x8 vf = __builtin_bit_cast(bf16x8, (u32x4){v0.x, v0.y, v1.x, v1.y});
#pragma unroll
                for (int u = 0; u < 2; ++u) O[u][dt] = __builtin_amdgcn_mfma_f32_16x16x32_bf16(pf[u], vf, O[u][dt], 0, 0, 0);
            }
        }
        __builtin_amdgcn_s_setprio(0);
        LAS bf16_t* Os = (LAS bf16_t*)(lds + 70656 + wid * 2304);
#pragma unroll
        for (int u = 0; u < 2; ++u) { const int i0 = i0p + 16 * u;
            float rd[4];
#pragma unroll
            for (int r = 0; r < 4; ++r) rd[r] = __shfl(rden[u], 4 * fq + r);
#pragma unroll
            for (int dt = 0; dt < 4; ++dt)
#pragma unroll
                for (int r = 0; r < 4; ++r) Os[(4 * fq + r) * 72 + dt * 16 + fr] = (bf16_t)(cvt_pk_bf16(O[u][dt][r] * rd[r], 0.f) & 0xffff);
            { const int orow = lane >> 2, seg = lane & 3; const LAS bf16_t* op = Os + orow * 72 + seg * 16;
              const u32x4 w0 = *(const LAS u32x4*)op, w1 = *(const LAS u32x4*)(op + 8);
              bf16_t* gp = Ob + (size_t)(rb + i0 + orow) * 1024 + head * 64 + seg * 16; st16(gp, w0); st16(gp + 8, w1); }
        }
    }
}

__device__ __forceinline__ int attn_item_of(int j) {
    if (gridDim.x != 256) return j;
    const int b = j >> 8, c = j & 255, xcd = c & 7, idx = c >> 3;
    return (b << 8) | ((xcd * 8 + (idx >> 2)) << 2) | (idx & 3);
}
__device__ __forceinline__ void attn_prompt_all(LAS unsigned char* lds, bf16_t* Qb, const bf16_t* Kb, const bf16_t* Vb, const float* sinks, bf16_t* Ob) {
    const int tid = opaque_tid();
    int it = blockIdx.x; AttnKV r;
    if (it < 1024) attn_load_kv(tid, attn_item_of(it), Kb, Vb, Qb, r);
    while (it < 1024) {
        __syncthreads();
        attn_store_kv(lds, tid, r);
        bf16x8 q01[2][2];
        q01[0][0] = r.q[0][0]; q01[0][1] = r.q[0][1]; q01[1][0] = r.q[1][0]; q01[1][1] = r.q[1][1];
        __syncthreads();
        const int nit = it + (int)gridDim.x;
        if (nit < 1024) attn_load_kv(tid, attn_item_of(nit), Kb, Vb, Qb, r);
        attn_prompt_compute(lds, attn_item_of(it), Qb, q01, sinks, Ob);
        it = nit;
    }
}

__device__ __forceinline__ void attn_sample_item(LAS unsigned char* lds, int item, const bf16_t* Qb, const bf16_t* Kb, const bf16_t* Vb, const float* ck, const float* cv, const float* sinks, bf16_t* Ob) {
    const int tid = opaque_tid(), lane = tid & 63, wid = tid >> 6;
    const int b = item >> 1, hh = item & 1;
    LAS float* qs = (LAS float*)lds;
    LAS float* sc = (LAS float*)(lds + 4096);
    const size_t row = (size_t)MPR + b;
    __syncthreads();
    if (tid < 256) { const unsigned w = *(const unsigned*)(Qb + row * 1024 + hh * 512 + tid * 2); qs[tid * 2] = bf_lo(w); qs[tid * 2 + 1] = bf_hi(w); }
    __syncthreads();
    { const int hl = tid >> 6, cb = tid & 63, h = hh * 8 + hl, kvh = h >> 2;
#pragma unroll
      for (int i = 0; i < 2; ++i) { const int c = cb + 64 * i; float acc = 0.f;
          if (c < 127) { const float* kp = ck + ((size_t)b * 128 + c + 1) * 256 + kvh * 64;
#pragma unroll
              for (int d = 0; d < 64; d += 4) { const f32x4 kv = *(const f32x4*)(kp + d); acc += kv[0] * qs[hl * 64 + d] + kv[1] * qs[hl * 64 + d + 1] + kv[2] * qs[hl * 64 + d + 2] + kv[3] * qs[hl * 64 + d + 3]; }
          } else { const bf16_t* kp = Kb + row * 256 + kvh * 64;
#pragma unroll
              for (int d = 0; d < 64; d += 2) { const unsigned w = *(const unsigned*)(kp + d); acc += bf_lo(w) * qs[hl * 64 + d] + bf_hi(w) * qs[hl * 64 + d + 1]; } }
          sc[hl * 128 + c] = acc; } }
    __syncthreads();
    { const int hl = wid, h = hh * 8 + hl; const float sink = sinks[h] * 1.4426950408889634f;
        const float s0 = sc[hl * 128 + lane], s1 = sc[hl * 128 + lane + 64];
        float mx = fmaxf(s0, s1);
#pragma unroll
        for (int o = 32; o >= 1; o >>= 1) mx = fmaxf(mx, __shfl_xor(mx, o));
        mx = fmaxf(mx, sink);
        const float e0 = __builtin_amdgcn_exp2f(s0 - mx), e1 = __builtin_amdgcn_exp2f(s1 - mx); const float sum = wave_sum(e0 + e1);
        const float rden = 1.0f / (sum + __builtin_amdgcn_exp2f(sink - mx));
        sc[hl * 128 + lane] = e0 * rden; sc[hl * 128 + lane + 64] = e1 * rden; }
    __syncthreads();
    { const int hl = tid >> 6, d = tid & 63, h = hh * 8 + hl, kvh = h >> 2; float o0 = 0.f;
      const float* vp = cv + ((size_t)b * 128 + 1) * 256 + kvh * 64 + d;
      for (int c0 = 0; c0 < 120; c0 += 8) { float v[8];
#pragma unroll
          for (int k = 0; k < 8; ++k) v[k] = vp[(size_t)(c0 + k) * 256];
#pragma unroll
          for (int k = 0; k < 8; ++k) o0 += sc[hl * 128 + c0 + k] * v[k]; }
      { float v[7];
#pragma unroll
          for (int k = 0; k < 7; ++k) v[k] = vp[(size_t)(120 + k) * 256];
#pragma unroll
          for (int k = 0; k < 7; ++k) o0 += sc[hl * 128 + 120 + k] * v[k]; }
      { const unsigned w = *(const unsigned*)(Vb + row * 256 + kvh * 64 + (d & ~1)); o0 += sc[hl * 128 + 127] * ((d & 1) ? bf_hi(w) : bf_lo(w)); }
      const float o1 = __shfl_xor(o0, 1);
      if (!(d & 1)) st4(Ob + row * 1024 + h * 64 + d, cvt_pk_bf16(o0, o1)); }
}

__device__ __forceinline__ void cache_shift_copy(const float* __restrict__ src, float* __restrict__ dst, int wg_first, int b_lo = 0, int b_hi = 128) {
    if ((int)blockIdx.x < wg_first) return;
    const int nthr = ((int)gridDim.x - wg_first) * 512, t0 = ((int)blockIdx.x - wg_first) * 512 + opaque_tid();
    constexpr int PER_B = 127 * 64;
    for (int i = b_lo * PER_B + t0; i < b_hi * PER_B; i += 4 * nthr) {
        f32x4 v[4];
#pragma unroll
        for (int k = 0; k < 4; ++k) { const int ii = i + k * nthr; if (ii < b_hi * PER_B) { const int b = ii / PER_B, r = ii - b * PER_B; v[k] = __builtin_nontemporal_load((const f32x4*)(src + ((size_t)b * 128 + 1) * 256 + (size_t)r * 4)); } }
#pragma unroll
        for (int k = 0; k < 4; ++k) { const int ii = i + k * nthr; if (ii < b_hi * PER_B) { const int b = ii / PER_B, r = ii - b * PER_B; __builtin_nontemporal_store(v[k], (f32x4*)(dst + (size_t)b * 128 * 256 + (size_t)r * 4)); } }
    }
}

__device__ __forceinline__ void store8f(float* o, const float (&f)[8]) { *(f32x4*)o = (f32x4){f[0], f[1], f[2], f[3]}; *(f32x4*)(o + 4) = (f32x4){f[4], f[5], f[6], f[7]}; }
__device__ __forceinline__ void load8f(const float* s, float (&f)[8]) { const f32x4 a = *(const f32x4*)s, b = *(const f32x4*)(s + 4); f[0] = a[0]; f[1] = a[1]; f[2] = a[2]; f[3] = a[3]; f[4] = b[0]; f[5] = b[1]; f[6] = b[2]; f[7] = b[3]; }

__device__ __forceinline__ void mix_elementwise(PP p, int l, const bf16_t* __restrict__ Ub, const bf16_t* BGb, const bf16_t* __restrict__ UPb, bf16_t* __restrict__ PLb, bf16_t* BGo) {
    const size_t gtid = (size_t)blockIdx.x * 512 + opaque_tid(), gstride = (size_t)gridDim.x * 512;
    const float* convw = p->in[7] + (size_t)l * 3 * 1024;
    const float* stc = p->in[2] + (size_t)l * 128 * 2 * 1024; const float* stp = p->in[3] + (size_t)l * 128 * 15 * 1024;
    const size_t gtid_x = (gridDim.x == 256) ? (size_t)(((blockIdx.x & 7u) * 32u + (blockIdx.x >> 3)) * 512u) + (gtid & 511) : gtid;
    for (size_t wi = gtid_x; wi < (size_t)(MPR / 32) * 128; wi += gstride) {
        const int c8 = (int)(wi & 127) * 8, run = (int)(wi >> 7); const int row0 = run * 32, t0 = row0 & (TSEQ - 1);
        const int g = c8 >> 8, win = 2 << g;
        float w0[8], w1[8], w2[8], u0[8], u1[8], s[8];
        load8f(convw + c8, w0); load8f(convw + 1024 + c8, w1); load8f(convw + 2048 + c8, w2);
        const size_t off0 = (size_t)row0 * 1024 + c8;
#pragma unroll
        for (int e = 0; e < 8; ++e) { u0[e] = 0.f; u1[e] = 0.f; s[e] = 0.f; }
        if (t0 > 0) {
            unpack8(*(const u32x4*)(Ub + off0 - 2048), u0); unpack8(*(const u32x4*)(Ub + off0 - 1024), u1);
            for (int k = 1; k <= win; ++k) { float v[8]; unpack8(*(const u32x4*)(UPb + off0 - (size_t)k * 1024), v);
#pragma unroll
                for (int e = 0; e < 8; ++e) s[e] += v[e]; }
        }
        u32x4 au = *(const u32x4*)(Ub + off0), ab = *(const u32x4*)(BGb + off0), ap = *(const u32x4*)(UPb + off0);
        u32x4 ao = (t0 >= win) ? *(const u32x4*)(UPb + off0 - (size_t)win * 1024) : (u32x4){0u, 0u, 0u, 0u};
        u32x4 bu = *(const u32x4*)(Ub + off0 + 1024), bb = *(const u32x4*)(BGb + off0 + 1024), bp = *(const u32x4*)(UPb + off0 + 1024);
        u32x4 bo = (t0 + 1 >= win) ? *(const u32x4*)(UPb + off0 + 1024 - (size_t)win * 1024) : (u32x4){0u, 0u, 0u, 0u};
#pragma unroll 2
        for (int j = 0; j < 32; ++j) {
            const size_t off = off0 + (size_t)j * 1024; const int t = t0 + j;
            float u2[8], bg[8], up[8], o[8], old[8];
            unpack8(au, u2); unpack8(ab, bg); unpack8(ap, up); unpack8(ao, old);
            au = bu; ab = bb; ap = bp; ao = bo;
            if (j < 30) {
                bu = *(const u32x4*)(Ub + off + 2048); bb = *(const u32x4*)(BGb + off + 2048); bp = *(const u32x4*)(UPb + off + 2048);
                bo = (t + 2 >= win) ? *(const u32x4*)(UPb + off + 2048 - (size_t)win * 1024) : (u32x4){0u, 0u, 0u, 0u}; }
            const float rcnt = 1.0f / (float)min(win, t + 1);
#pragma unroll
            for (int e = 0; e < 8; ++e) { s[e] += up[e] - old[e]; o[e] = bg[e] * (w0[e] * u0[e] + w1[e] * u1[e] + w2[e] * u2[e]); u0[e] = u1[e]; u1[e] = u2[e]; }
            st16(BGo + off, pack8(o));
#pragma unroll
            for (int e = 0; e < 8; ++e) o[e] = s[e] * rcnt - up[e];
            st16(PLb + off, pack8(o));
        }
    }
    for (size_t i = gtid; i < (size_t)NS * 128; i += gstride) {
        const int b = (int)(i >> 7), c8 = (int)(i & 127) * 8; const size_t off = ((size_t)MPR + b) * 1024 + c8;
        float w0[8], w1[8], w2[8], u0[8], u1[8], u2[8], bg[8], up[8], s[8], o[8];
        load8f(convw + c8, w0); load8f(convw + 1024 + c8, w1); load8f(convw + 2048 + c8, w2);
        unpack8(*(const u32x4*)(Ub + off), u2); unpack8(*(const u32x4*)(BGb + off), bg); unpack8(*(const u32x4*)(UPb + off), up);
        const int g = c8 >> 8, win = 2 << g;
#pragma unroll
        for (int e = 0; e < 8; ++e) s[e] = up[e];
        load8f(stc + (size_t)(b * 2 + 0) * 1024 + c8, u0); load8f(stc + (size_t)(b * 2 + 1) * 1024 + c8, u1);
        for (int k = 1; k < win; ++k) { float v[8]; load8f(stp + (size_t)(b * 15 + 15 - k) * 1024 + c8, v);
#pragma unroll
            for (int e = 0; e < 8; ++e) s[e] += v[e]; }
        const float rcnt = 1.0f / (float)win;
#pragma unroll
        for (int e = 0; e < 8; ++e) o[e] = bg[e] * (w0[e] * u0[e] + w1[e] * u1[e] + w2[e] * u2[e]);
        st16(BGo + off, pack8(o));
#pragma unroll
        for (int e = 0; e < 8; ++e) o[e] = s[e] * rcnt - up[e];
        st16(PLb + off, pack8(o));
    }
}
__device__ __forceinline__ void state_outputs(PP p, int l, const bf16_t* Ub, const bf16_t* UPb, const bf16_t* Kb, const bf16_t* Vb) {
    const size_t gtid = (size_t)blockIdx.x * 512 + opaque_tid(), gstride = (size_t)gridDim.x * 512;
    const float* stc = p->in[2] + (size_t)l * 128 * 2 * 1024; const float* stp = p->in[3] + (size_t)l * 128 * 15 * 1024;
    float* out = p->out; float f[8];
    for (size_t i = gtid; i < 4 * 2 * 128; i += gstride) { const int b = (int)(i >> 8), r = (int)(i >> 7) & 1, c8 = (int)(i & 127) * 8;
        unpack8(*(const u32x4*)(Ub + ((size_t)b * TSEQ + TSEQ - 2 + r) * 1024 + c8), f); store8f(out + O_PC + (size_t)l * 8192 + (b * 2 + r) * 1024 + c8, f); }
    for (size_t i = gtid; i < 4 * 15 * 128; i += gstride) { const int b = (int)(i / 1920), r = (int)(i >> 7) % 15, c8 = (int)(i & 127) * 8;
        unpack8(*(const u32x4*)(UPb + ((size_t)b * TSEQ + TSEQ - 15 + r) * 1024 + c8), f); store8f(out + O_PP + (size_t)l * 61440 + (b * 15 + r) * 1024 + c8, f); }
    for (size_t i = gtid; i < 4 * 128 * 32; i += gstride) { const int b = (int)(i >> 12), sidx = (int)(i >> 5) & 127, c8 = (int)(i & 31) * 8; const size_t so = ((size_t)b * TSEQ + TSEQ - 128 + sidx) * 256 + c8, oo = (size_t)l * 131072 + (b * 128 + sidx) * 256 + c8;
        unpack8(*(const u32x4*)(Kb + so), f); store8f(out + O_PK + oo, f); unpack8(*(const u32x4*)(Vb + so), f); store8f(out + O_PV + oo, f); }
    for (size_t i = gtid; i < 128 * 2 * 128; i += gstride) { const int b = (int)(i >> 8), r = (int)(i >> 7) & 1, c8 = (int)(i & 127) * 8;
        if (r == 0) load8f(stc + (size_t)(b * 2 + 1) * 1024 + c8, f); else unpack8(*(const u32x4*)(Ub + ((size_t)MPR + b) * 1024 + c8), f);
        store8f(out + O_SC + (size_t)l * 262144 + (b * 2 + r) * 1024 + c8, f); }
    for (size_t i = gtid; i < 128 * 15 * 128; i += gstride) { const int b = (int)(i / 1920), r = (int)(i >> 7) % 15, c8 = (int)(i & 127) * 8;
        if (r < 14) load8f(stp + (size_t)(b * 15 + r + 1) * 1024 + c8, f); else unpack8(*(const u32x4*)(UPb + ((size_t)MPR + b) * 1024 + c8), f);
        store8f(out + O_SP + (size_t)l * 1966080 + (b * 15 + r) * 1024 + c8, f); }
    for (size_t i = gtid; i < (size_t)128 * 32; i += gstride) { const int b = (int)(i >> 5), c8 = (int)(i & 31) * 8; const size_t oo = (size_t)l * 4194304 + ((size_t)b * 128 + 127) * 256 + c8;
        unpack8(*(const u32x4*)(Kb + ((size_t)MPR + b) * 256 + c8), f); store8f(out + O_SK + oo, f); unpack8(*(const u32x4*)(Vb + ((size_t)MPR + b) * 256 + c8), f); store8f(out + O_SV + oo, f); }
}

#define XB_TMO      128
#define XB_XCNT(j)  (256  + 64 * (j))
#define XB_XSUB(j)  (1280 + 64 * (j))
#define XB_XGEN(j)  (2304 + 64 * (j))
#define XB_TOP      3328
#define XB_TOPGEN   3392
#define XCD_BAR_WORDS 3456
#define XB_SPIN_CAP (1u << 16)
__device__ __forceinline__ unsigned xb_ld(unsigned* p)              { return __hip_atomic_load(p, __ATOMIC_RELAXED, __HIP_MEMORY_SCOPE_AGENT); }
__device__ __forceinline__ unsigned xb_add(unsigned* p, unsigned v) { return __hip_atomic_fetch_add(p, v, __ATOMIC_RELAXED, __HIP_MEMORY_SCOPE_AGENT); }
__device__ __forceinline__ unsigned xb_xcc_id() { return (unsigned)__builtin_amdgcn_s_getreg((3 << 11) | 20) & 0xFu; }
#define XB_SPIN(cond, bar) do { unsigned _sp = 0; while (cond) { __builtin_amdgcn_s_sleep(8); \
    if ((++_sp & 255u) == 0u) { if (xb_ld(&(bar)[XB_TMO])) break; if (_sp > XB_SPIN_CAP) { atomicAdd(&(bar)[XB_TMO], 1u); break; } } } } while (0)
struct XcdBarrier { unsigned* bar; unsigned x; volatile LAS unsigned* st; };
__device__ __forceinline__ XcdBarrier xcd_barrier_post(unsigned* bar, volatile LAS unsigned* st) {
    XcdBarrier b; b.bar = bar; b.x = xb_xcc_id(); b.st = st;
    if (threadIdx.x == 0) (void)xb_add(&bar[XB_XCNT(b.x)], 1u);
    return b;
}
__device__ __forceinline__ void xcd_barrier_complete(unsigned* bar, unsigned x, unsigned& nloc, unsigned& nx) {
    const unsigned G = gridDim.x * gridDim.y * gridDim.z;
    unsigned sum, cnt, mine, sp = 0u;
    for (;;) {
        sum = 0u; cnt = 0u; mine = 0u;
#pragma unroll
        for (unsigned j = 0; j < 16; ++j) { const unsigned c = xb_ld(&bar[XB_XCNT(j)]); sum += c; cnt += (c > 0u) ? 1u : 0u; mine = (j == x) ? c : mine; }
        if (sum == G) break;
        __builtin_amdgcn_s_sleep(1);
        if ((++sp & 255u) == 0u) { if (xb_ld(&bar[XB_TMO])) break; if (sp > XB_SPIN_CAP) { atomicAdd(&bar[XB_TMO], 1u); break; } }
    }
    nloc = mine > 0u ? mine : 1u; nx = cnt > 0u ? cnt : 1u;
}
__device__ __forceinline__ void xcd_barrier(const XcdBarrier& b) {
    asm volatile("s_waitcnt vmcnt(0)" ::: "memory");
    __syncthreads();
    if (threadIdx.x == 0) {
        unsigned* bar = b.bar;
        __builtin_amdgcn_s_waitcnt(0);
        unsigned nloc = b.st[0], nx = b.st[1];
        if (nloc == 0u) { xcd_barrier_complete(bar, b.x, nloc, nx); b.st[0] = nloc; b.st[1] = nx; }
        const unsigned old = xb_add(&bar[XB_XSUB(b.x)], 1u);
        const unsigned gen = old / nloc;
        if (old + 1u == (gen + 1u) * nloc) {
            __builtin_amdgcn_fence(__ATOMIC_RELEASE, "agent");
            asm volatile("s_waitcnt vmcnt(0)" ::: "memory");
            const unsigned og = xb_add(&bar[XB_TOP], 1u);
            const unsigned tg = og / nx;
            if (og + 1u == (tg + 1u) * nx) xb_add(&bar[XB_TOPGEN], 1u);
            else XB_SPIN(xb_ld(&bar[XB_TOPGEN]) == tg, bar);
            __builtin_amdgcn_fence(__ATOMIC_ACQUIRE, "agent");
            xb_add(&bar[XB_XGEN(b.x)], 1u);
            asm volatile("s_waitcnt vmcnt(0)" ::: "memory");
        } else {
            XB_SPIN(xb_ld(&bar[XB_XGEN(b.x)]) == gen, bar);
            __builtin_amdgcn_fence(__ATOMIC_ACQUIRE, "agent");
            asm volatile("s_waitcnt vmcnt(0)" ::: "memory");
        }
    }
    __syncthreads();
}

#ifndef PHMASK
#define PHMASK 0xFFFF
#endif
#define PH(n) if (PHMASK & (1 << (n)))
#define WSPTRS() PP p = (PP)__builtin_amdgcn_kernarg_segment_ptr(); OPQ_S(p); unsigned char* ws = p->ws; \
    bf16_t* W = (bf16_t*)(ws + WS_W); bf16_t* Hb = (bf16_t*)(ws + WS_H); \
    bf16_t* R1 = (bf16_t*)(ws + WS_R1); bf16_t* R2 = (bf16_t*)(ws + WS_R2); bf16_t* R3 = (bf16_t*)(ws + WS_R3); bf16_t* R4 = (bf16_t*)(ws + WS_R4); \
    bf16_t* Kb = (bf16_t*)(ws + WS_R5); bf16_t* Vb = Kb + (size_t)MP * 256; bf16_t* PLb = (bf16_t*)(ws + WS_R5 + UNIT); \
    bf16_t* MIXf = (bf16_t*)(ws + WS_R2); bf16_t* Ff = (bf16_t*)(ws + WS_R5); bf16_t* X1b = (bf16_t*)(ws + WS_R5 + UNIT); (void)X1b; f32x2* rope = (f32x2*)(ws + WS_ROPE); \
    float* yp = p->out + O_YP; float* ys = p->out + O_YS; \
    (void)W; (void)Hb; (void)R1; (void)R2; (void)R3; (void)R4; (void)Kb; (void)Vb; (void)PLb; (void)MIXf; (void)Ff; (void)rope; (void)yp; (void)ys

__global__ void __launch_bounds__(512, 2) fwd_megakernel(Params p_unused) {
    extern __shared__ __attribute__((aligned(16))) unsigned char shm[];
    LAS unsigned char* lds = (LAS unsigned char*)shm;
    cg::grid_group grid = cg::this_grid();
    volatile LAS unsigned* xb_st = (volatile LAS unsigned*)(lds + STAGE_BYTES);
    if (threadIdx.x == 0) { xb_st[0] = 0u; xb_st[1] = 0u; }
    __syncthreads();
    const XcdBarrier xb = xcd_barrier_post((unsigned*)(((PP)__builtin_amdgcn_kernarg_segment_ptr())->ws + WS_BAR), xb_st);
#define GRID_SYNC() xcd_barrier(xb)
    if (((PP)__builtin_amdgcn_kernarg_segment_ptr())->out == nullptr) grid.sync();
    PH(0) { WSPTRS(); rope_table(rope); }
    PH(1) { WSPTRS(); convert_layer(lds, p, 0, 1, 0); }
    PH(2) { WSPTRS(); float* RS0 = (float*)(ws + WS_RS); row_phase(p->in[0], p->in[1], nullptr, nullptr, nullptr, Hb, nullptr, nullptr, RS0, nullptr, 0, 0, MREAL, 0); }
    GRID_SYNC();

#define STILE(p, ld) ((const char*)((p) + (size_t)MPR * (ld)))
#define SIDEPTRS() bf16_t* GS = (bf16_t*)(ws + WS_GS); bf16_t* MS = (bf16_t*)(ws + WS_MS); float* MIXP = (float*)(ws + WS_MIXP); float* FP = (float*)(ws + WS_FP); float* RS0 = (float*)(ws + WS_RS); float* RS1 = RS0 + MP; (void)GS; (void)MS; (void)MIXP; (void)FP; (void)RS0; (void)RS1
    for (int l = 0; l < 2; ++l) {
        PH(3) { WSPTRS(); SIDEPTRS(); const bf16_t* XA_ = l == 0 ? (const bf16_t*)Hb : (const bf16_t*)yp;     PhaseOrder S; S.init(XA_, W + WO_IN, 1024, 1024, 0, 22, true);
            S.X = Extra{34, 34, STILE(XA_, 1024), (const char*)(W + WO_IN), 0, 0, 0, (size_t)512 * 1024};
            EpiMain E{R1, R2, R3, R4, Kb, Vb, (const f32x4*)rope, GS, RS0}; gemm_phase(lds, 1024, 1024, 1024, S, E);
            convert_layer(lds, p, l, 2, 34);
            cache_shift_copy(p->in[4], p->out + O_SK, 34, l * 64, l * 64 + 64); }
        GRID_SYNC();
        PH(4) { WSPTRS(); attn_prompt_all(lds, R4, Kb, Vb, p->in[11] + l * 16, R4); }
        PH(5) { WSPTRS(); for (int it = blockIdx.x; it < 256; it += gridDim.x) attn_sample_item(lds, it, R4, Kb, Vb, p->in[4] + (size_t)l * 128 * 128 * 256, p->in[5] + (size_t)l * 128 * 128 * 256, p->in[11] + l * 16, R4); }
        PH(6) { WSPTRS(); mix_elementwise(p, l, R1, R2, R3, PLb, R2); }
        PH(6) { WSPTRS(); state_outputs(p, l, R1, R3, Kb, Vb); }
        GRID_SYNC();
        PH(7) { WSPTRS(); SIDEPTRS(); const bf16_t* XA_ = l == 0 ? (const bf16_t*)Hb : (const bf16_t*)yp;     PhaseOrder S; S.init(XA_, W + WO_IN + (size_t)5632 * 1024, 1024, 1024, 0, 4, true); EpiAct<0> E{R1, 1024, RS0}; gemm_phase(lds, 1024, 1024, 1024, S, E); }
        PH(8) { WSPTRS(); SIDEPTRS(); PhaseOrder S; S.init(R2, W + WO_CO, 1024, 1024, 0, 4, true);
            S.X = Extra{8, 4, STILE(R2, 1024), (const char*)(W + WO_CO), 2 * UNIT, (WO_AO - WO_CO) * 2, 0, (size_t)512 * 1024};
            EpiGate E{R1, R1, false, GS, MS, 0, 2}; gemm_phase(lds, 1024, 1024, 1024, S, E); }
        PH(7) { WSPTRS(); SIDEPTRS(); const bf16_t* XA_ = l == 0 ? (const bf16_t*)Hb : (const bf16_t*)yp;     PhaseOrder S; S.init(XA_, W + WO_IN + (size_t)7680 * 1024, 1024, 1024, 0, 4, true); EpiAct<0> E{R3, 1024, RS0}; gemm_phase(lds, 1024, 1024, 1024, S, E); }
        PH(10) { WSPTRS(); SIDEPTRS(); PhaseOrder S; S.init(R4, W + WO_AO, 1024, 1024, 0, 4, true); EpiGate E{R1, R3, true, GS, MS, 0, 0}; gemm_phase(lds, 1024, 1024, 1024, S, E);
            cache_shift_copy(p->in[5] + (size_t)l * 128 * 128 * 256, p->out + O_SV + (size_t)l * 4194304, 8); }
        PH(7) { WSPTRS(); SIDEPTRS(); const bf16_t* XA_ = l == 0 ? (const bf16_t*)Hb : (const bf16_t*)yp;     PhaseOrder S; S.init(XA_, W + WO_IN + (size_t)6656 * 1024, 1024, 1024, 0, 4, true); EpiAct<0> E{Kb, 1024, RS0};     gemm_phase(lds, 1024, 1024, 1024, S, E); }
        PH(9) { WSPTRS(); SIDEPTRS(); PhaseOrder S; S.init(PLb, W + WO_POOL, 1024, 256, 256, 4, true);
            S.X = Extra{4, 4, STILE(PLb, 1024), (const char*)(W + WO_POOL), 0, 0, 512, (size_t)512 * 256};
            EpiGate E{R1, Kb, true, GS, MS, 1, 1}; int kpool = 256; OPQ_S(kpool); gemm_phase(lds, kpool, 1024, 256, S, E); }
        GRID_SYNC();
        PH(11) { WSPTRS(); SIDEPTRS(); PhaseOrder S; S.init(R1, W + WO_MIX, 1024, 1024, 0, 4, true); EpiOut E{MIXf, MIXP}; gemm_phase(lds, 1024, 1024, 1024, S, E); }
        GRID_SYNC();
        PH(11) { WSPTRS(); SIDEPTRS(); PhaseOrder S; S.init(R1, W + WO_MIX, 1024, 1024, 0, 4, false);
            S.X = Extra{12, 4, (const char*)MS, (const char*)(W + WO_MIX), SIDE * 2, 0, 0, (size_t)512 * 1024};
            EpiOut E{MIXf, MIXP}; gemm_phase(lds, 1024, 1024, 1024, S, E); }
        PH(12) { WSPTRS(); SIDEPTRS(); const bf16_t* XA_ = l == 0 ? (const bf16_t*)Hb : (const bf16_t*)yp;     row_phase(nullptr, nullptr, XA_, nullptr, nullptr, X1b, MIXf, p->in[15] + l * 1024, RS1, MIXP, 3, 0, MPR, 12); }
        GRID_SYNC();
        PH(12) { WSPTRS(); SIDEPTRS(); const bf16_t* XA_ = l == 0 ? (const bf16_t*)Hb : (const bf16_t*)yp;     row_phase(nullptr, nullptr, XA_, nullptr, nullptr, X1b, MIXf, p->in[15] + l * 1024, RS1, MIXP, 3, MPR, MREAL, 0); }
        GRID_SYNC();
        PH(13) { WSPTRS(); SIDEPTRS(); PhaseOrder S; S.init(X1b, W + WO_UP, 1024, 1024, 0, 16, true);
            S.X = Extra{16, 16, STILE(X1b, 1024), (const char*)(W + WO_UP), 0, 0, 0, (size_t)512 * 1024};
            EpiAct<1> E{R1, DFF, RS1}; gemm_phase(lds, 1024, 1024, 1024, S, E);
            if (l == 0) convert_layer(lds, p, 1, 1, 16); else cache_shift_copy(p->in[4] + (size_t)128 * 128 * 256, p->out + O_SK + (size_t)4194304, 16); }
        GRID_SYNC();
        PH(14) { WSPTRS(); SIDEPTRS(); PhaseOrder S; S.init(R1, W + WO_DN, DFF, DFF, 0, 4, true); EpiOut E{Ff, FP}; gemm_phase(lds, DFF, DFF, DFF, S, E); }
        GRID_SYNC();
        PH(14) { WSPTRS(); SIDEPTRS(); PhaseOrder S; S.init(R1, W + WO_DN, DFF, DFF, 0, 4, false);
            S.X = Extra{16, 4, STILE(R1, DFF), (const char*)(W + WO_DN), 2048, 2048, 0, (size_t)512 * DFF};
            EpiOut E{Ff, FP}; gemm_phase(lds, 1024, DFF, DFF, S, E); }
        PH(12) { WSPTRS(); SIDEPTRS(); row_phase(nullptr, nullptr, X1b, l == 0 ? nullptr : yp, l == 0 ? nullptr : ys, l == 0 ? (bf16_t*)yp : nullptr, Ff, p->in[17] + l * 1024, l == 0 ? RS0 : nullptr, FP, 4, 0, MPR, 16); }
        GRID_SYNC();
        PH(12) { WSPTRS(); SIDEPTRS(); row_phase(nullptr, nullptr, X1b, l == 0 ? nullptr : yp, l == 0 ? nullptr : ys, l == 0 ? (bf16_t*)yp : nullptr, Ff, p->in[17] + l * 1024, l == 0 ? RS0 : nullptr, FP, 4, MPR, MREAL, 0); }
        if (l == 0) GRID_SYNC();
    }
}

extern "C" void kernel_launch(void* const* d_in, const int* in_sizes, int n_in, void* d_out, int out_size, void* d_ws, size_t ws_size, hipStream_t stream) {
    constexpr size_t kDynLds = STAGE_BYTES + 64;
    static int grid_blocks = 0;
    if (!grid_blocks) {
        int dev = 0, cus = 0, per_cu = 0;
        hipGetDevice(&dev);
        hipDeviceGetAttribute(&cus, hipDeviceAttributeMultiprocessorCount, dev);
        hipFuncSetAttribute((const void*)fwd_megakernel, hipFuncAttributeMaxDynamicSharedMemorySize, (int)kDynLds);
        hipOccupancyMaxActiveBlocksPerMultiprocessor(&per_cu, (const void*)fwd_megakernel, 512, kDynLds);
        if (per_cu < 1) per_cu = 1;
        grid_blocks = cus * per_cu;
        if (ws_size < WS_END) fprintf(stderr, "kernel_launch: workspace too small: %zu < %zu\n", ws_size, (size_t)WS_END);
    }
    Params p{};
    for (int i = 0; i < 20; ++i) p.in[i] = (const float*)d_in[i];
    p.out = (float*)d_out; p.ws = (unsigned char*)d_ws;
    (void)hipMemsetAsync((char*)d_ws + WS_BAR, 0, 16384, stream);
    void* args[] = {&p};
    hipError_t e = hipLaunchCooperativeKernel((const void*)fwd_megakernel, dim3(grid_blocks), dim3(512), args, kDynLds, stream);
    if (e != hipSuccess) fprintf(stderr, "cooperative launch failed: %s (grid %d)\n", hipGetErrorString(e), grid_blocks);
}
```

```cpp
#include <hip/hip_runtime.h>
#include <hip/hip_cooperative_groups.h>
#include <cstdio>
namespace cg = cooperative_groups;

#define LAS __attribute__((address_space(3)))
typedef unsigned short bf16_t;
typedef short bf16x8 __attribute__((ext_vector_type(8)));
typedef float f32x4 __attribute__((ext_vector_type(4)));
typedef float f32x2 __attribute__((ext_vector_type(2)));
typedef unsigned u32x4 __attribute__((ext_vector_type(4)));
typedef unsigned u32x2 __attribute__((ext_vector_type(2)));

constexpr int DM = 1024, TSEQ = 8192, MPR = 32768, NS = 128, MREAL = MPR + NS, MP = 33024;
constexpr int NPROJ = 8704, DFF = 4096, NMAIN = 5632;
constexpr float RMS_EPS = 1e-6f;
constexpr size_t O_YP = 0, O_YS = O_YP + (size_t)MPR * DM, O_PC = O_YS + (size_t)NS * DM, O_PP = O_PC + 2 * 4 * 2 * 1024,
                 O_PK = O_PP + 2 * 4 * 15 * 1024, O_PV = O_PK + 2 * 4 * 128 * 256, O_SC = O_PV + 2 * 4 * 128 * 256,
                 O_SP = O_SC + 2 * 128 * 2 * 1024, O_SK = O_SP + 2 * 128 * 15 * 1024, O_SV = O_SK + (size_t)2 * 128 * 128 * 256;
constexpr size_t UNIT = (size_t)MP * 1024 * 2;
constexpr size_t WS_ROPE = 4096, ROPE_BYTES = (size_t)8193 * 32 * 8;
constexpr size_t WS_W = WS_ROPE + ((ROPE_BYTES + 4095) / 4096) * 4096;
constexpr size_t WO_IN = 0, WO_CO = WO_IN + (size_t)8704 * 1024, WO_POOL = WO_CO + 1024 * 1024, WO_AO = WO_POOL + 1024 * 256,
                 WO_MIX = WO_AO + 1024 * 1024, WO_UP = WO_MIX + 1024 * 1024, WO_DN = WO_UP + 4096 * 1024, WO_END = WO_DN + 4096 * 1024;
constexpr size_t WS_H = WS_W + ((WO_END * 2 + 4095) / 4096) * 4096;
constexpr size_t WS_R1 = WS_H + UNIT, WS_R2 = WS_R1 + UNIT, WS_R3 = WS_R2 + UNIT, WS_R4 = WS_R3 + UNIT, WS_R5 = WS_R4 + UNIT, WS_GS = WS_R5 + 2 * UNIT, SIDE = (size_t)256 * 1024, WS_MS = WS_GS + 3 * SIDE * 2, WS_MIXP = WS_MS + 3 * SIDE * 2, WS_FP = WS_MIXP + 3 * SIDE * 4, WS_RS = WS_FP + 4 * SIDE * 4, WS_BAR = WS_RS + 2 * (size_t)MP * 4 + 4096 - (2 * (size_t)MP * 4) % 4096, WS_END = WS_BAR + 16384;

struct Params { const float* in[20]; float* out; unsigned char* ws; };
typedef const __attribute__((address_space(4))) Params* PP;

typedef __bf16 bf16v2 __attribute__((ext_vector_type(2)));
__device__ __forceinline__ unsigned cvt_pk_bf16(float lo, float hi) { return __builtin_bit_cast(unsigned, __builtin_convertvector((f32x2){lo, hi}, bf16v2)); }
__device__ __forceinline__ float bf_lo(unsigned w) { return __uint_as_float(w << 16); }
__device__ __forceinline__ float bf_hi(unsigned w) { return __uint_as_float(w & 0xffff0000u); }
__device__ __forceinline__ void unpack8(const u32x4 w, float (&f)[8]) {
    f[0] = bf_lo(w.x); f[1] = bf_hi(w.x); f[2] = bf_lo(w.y); f[3] = bf_hi(w.y); f[4] = bf_lo(w.z); f[5] = bf_hi(w.z); f[6] = bf_lo(w.w); f[7] = bf_hi(w.w); }
__device__ __forceinline__ u32x4 pack8(const float (&f)[8]) { u32x4 w; w.x = cvt_pk_bf16(f[0], f[1]); w.y = cvt_pk_bf16(f[2], f[3]); w.z = cvt_pk_bf16(f[4], f[5]); w.w = cvt_pk_bf16(f[6], f[7]); return w; }
__device__ __forceinline__ float wave_sum(float v) {
#pragma unroll
    for (int o = 32; o >= 1; o >>= 1) v += __shfl_xor(v, o);
    return v; }
__device__ __forceinline__ int opaque_tid() { int t = threadIdx.x; asm volatile("" : "+v"(t)); return t; }
#define OPQ_S(x) asm volatile("" : "+s"(x))
__device__ __forceinline__ float sigmoidf_(float x) { return __builtin_amdgcn_rcpf(1.0f + __expf(-x)); }

__device__ __forceinline__ void st16(void* p, u32x4 v) { *(u32x4*)p = v; }
__device__ __forceinline__ void st16(void* p, f32x4 v) { *(f32x4*)p = v; }
__device__ __forceinline__ void st8(void* p, u32x2 v) { *(u32x2*)p = v; }
__device__ __forceinline__ void st4(void* p, unsigned v) { *(unsigned*)p = v; }

constexpr int BM = 256, BK = 64, HALF = 128, HTB = HALF * BK * 2, STAGE_BYTES = 8 * HTB, NXCD = 8, WGM = 8;
__device__ __forceinline__ int lds_byte(int r, int c) { const int st = (r >> 4) * 2 + (c >> 5), rr = r & 15, cc = c & 31, ob = rr * 64 + cc * 2; return st * 1024 + (ob ^ (((ob >> 9) & 1) << 5)); }
__device__ __forceinline__ void stage_rc(int b, int& R, int& C) { const int st = b / 1024, sb = b % 1024, swz = sb ^ (((sb >> 9) & 1) << 5); R = (st >> 1) * 16 + swz / 64; C = (st & 1) * 32 + (swz % 64) / 2; }
__device__ __forceinline__ int perm32(int rho) { const int n = rho >> 4, i = rho & 15; return 8 * (i >> 2) + 4 * n + (i & 3); }

struct Unit { int pm, pn, tag; const char* a; const char* b; };

struct Extra { int n, per; const char* a0; const char* b0; size_t a_tag_bytes, b_tag_bytes, a_pn_bytes, b_pn_bytes;
    __device__ __forceinline__ bool get(int e, Unit& u) const { if (e >= n) return false; const int tag = e / per, pn = e - tag * per;
        u.pm = 128; u.pn = pn; u.tag = tag; u.a = a0 + (size_t)tag * a_tag_bytes + (size_t)pn * a_pn_bytes; u.b = b0 + (size_t)tag * b_tag_bytes + (size_t)pn * b_pn_bytes; return true; } };
struct PhaseOrder {
    const char* A; const char* Bt; size_t tstepA, tstepB, a_pn_bytes; int nN, nwg, rounds, G, c; Extra X;
    __device__ __forceinline__ void init(const void* A_, const void* Bt_, int lda, int ldb, int a_pn_cols, int nN_, bool prompt) {
        A = (const char*)A_; Bt = (const char*)Bt_; tstepA = (size_t)512 * lda; tstepB = (size_t)512 * ldb; a_pn_bytes = (size_t)a_pn_cols * 2; nN = nN_; nwg = prompt ? 128 * nN_ : 0;
        G = (int)gridDim.x; c = (int)blockIdx.x; rounds = (nwg + G - 1) / G; X = Extra{0, 1, nullptr, nullptr, 0, 0, 0, 0}; }
    __device__ __forceinline__ bool next(int i, Unit& u) const {
        if (i < rounds) { const long L = (long)i * G + c; if (L >= nwg) return false;
            int wgid = (int)L; { const int q = nwg / NXCD, r = nwg % NXCD, xcd = wgid % NXCD, off = wgid / NXCD; wgid = (xcd < r ? xcd * (q + 1) : r * (q + 1) + (xcd - r) * q) + off; }
            const int nig = WGM * nN, gid = wgid / nig, fm = gid * WGM;
            u.pm = fm + ((wgid % nig) % WGM); u.pn = (wgid % nig) / WGM; u.tag = -1; u.a = A + (size_t)u.pm * tstepA + (size_t)u.pn * a_pn_bytes; u.b = Bt + (size_t)u.pn * tstepB; return true; }
        if (i == rounds) return X.get(c, u);
        return false;
    }
};

typedef f32x4 Acc[2][2][4][2];

template <class Epi>
__device__ __forceinline__ void gemm_phase(LAS unsigned char* lds, const int K, const int lda, const int ldb, const PhaseOrder& S, const Epi& E) {
    const int tid = opaque_tid(), wid = __builtin_amdgcn_readfirstlane(tid >> 6), lane = tid & 63, wr = wid >> 2, wc = wid & 3, fr = lane & 15, fq = lane >> 4;
    const int nt = K / BK;
    unsigned voffA[2], voffB[2];
#pragma unroll
    for (int i = 0; i < 2; ++i) { int R, C; stage_rc(tid * 16 + i * 8192, R, C); const int Rb = Epi::PERM ? ((R & ~31) + perm32(R & 31)) : R;
        voffA[i] = (unsigned)(R * lda + C) * 2u; voffB[i] = (unsigned)(Rb * ldb + C) * 2u; }
    const size_t kstep = (size_t)(BK * 2);
    const size_t hstepA = (size_t)HALF * lda * 2, hstepB = (size_t)HALF * ldb * 2;
    const unsigned ldsw = (unsigned)wid * 1024u;
    const int aoff = lds_byte(wr * 64 + fr, fq * 8), boff = lds_byte(wc * 32 + fr, fq * 8);
#define PG8_SA(b, h) (((b) * 2 + (h)) * HTB)
#define PG8_SB(b, h) ((4 + (b) * 2 + (h)) * HTB)
#define PG8_STAGE(bufoff, gbase, voff) do { _Pragma("unroll") for (int _i = 0; _i < 2; ++_i) \
        __builtin_amdgcn_global_load_lds((const unsigned*)((const char*)(gbase) + (voff)[_i]), (LAS unsigned*)(lds + (bufoff) + ldsw + _i * 8192), 16, 0, 0); } while (0)
#define PG8_LDA(dst, b, h) do { _Pragma("unroll") for (int m = 0; m < 4; ++m) _Pragma("unroll") for (int k = 0; k < 2; ++k) dst[m][k] = *(const LAS bf16x8*)(lds + PG8_SA(b, h) + aoff + m * 2048 + k * 1024); } while (0)
#define PG8_LDB(dst, b, h) do { _Pragma("unroll") for (int n = 0; n < 2; ++n) _Pragma("unroll") for (int k = 0; k < 2; ++k) dst[n][k] = *(const LAS bf16x8*)(lds + PG8_SB(b, h) + boff + n * 2048 + k * 1024); } while (0)
#define PG8_MMA(ai, bj, At, Bt) do { __builtin_amdgcn_s_setprio(1); _Pragma("unroll") for (int m = 0; m < 4; ++m) _Pragma("unroll") for (int n = 0; n < 2; ++n) _Pragma("unroll") for (int k = 0; k < 2; ++k) \
        acc[ai][bj][m][n] = __builtin_amdgcn_mfma_f32_16x16x32_bf16(Bt[n][k], At[m][k], acc[ai][bj][m][n], 0, 0, 0); __builtin_amdgcn_s_setprio(0); } while (0)
#define PG8_WAIT_V(n) asm volatile("s_waitcnt vmcnt(" #n ")" ::: "memory")
#define PG8_WAIT_L(n) asm volatile("s_waitcnt lgkmcnt(" #n ")" ::: "memory")
#define PG8_BAR __builtin_amdgcn_s_barrier()
#define PG8_SCHED __builtin_amdgcn_sched_barrier(0)
    Unit cur, nxt; int ui = 0;
    if (!S.next(0, cur)) return;
    Acc acc;
#pragma unroll
    for (int a = 0; a < 2; ++a)
#pragma unroll
        for (int b = 0; b < 2; ++b)
#pragma unroll
            for (int m = 0; m < 4; ++m)
#pragma unroll
                for (int n = 0; n < 2; ++n) acc[a][b][m][n] = (f32x4){0.f, 0.f, 0.f, 0.f};
    bf16x8 At[4][2], B0[2][2], B1[2][2];
    const char* cA = cur.a; const char* cB = cur.b;
    PG8_STAGE(PG8_SB(0, 0), cB, voffB); PG8_STAGE(PG8_SA(0, 0), cA, voffA); PG8_STAGE(PG8_SB(0, 1), cB + hstepB, voffB); PG8_STAGE(PG8_SA(0, 1), cA + hstepA, voffA);
    if (wr == 1) PG8_BAR;
    PG8_WAIT_V(4); PG8_BAR;
    PG8_STAGE(PG8_SB(1, 0), cB + kstep, voffB); PG8_STAGE(PG8_SA(1, 0), cA + kstep, voffA); PG8_STAGE(PG8_SB(1, 1), cB + hstepB + kstep, voffB);
    PG8_WAIT_V(6); PG8_BAR;
    for (;;) {
        const bool has_next = S.next(ui + 1, nxt);
        const char* nA = has_next ? nxt.a : cA; const char* nB = has_next ? nxt.b : cB;
        for (int t = 0; t < nt; t += 2) {
            const bool last = (t == nt - 2);
            const char* a1 = cA + (size_t)(t + 1) * kstep;
            const char* a2 = last ? nA : cA + (size_t)(t + 2) * kstep; const char* b2 = last ? nB : cB + (size_t)(t + 2) * kstep;
            const char* a3 = a2 + kstep; const char* b3 = b2 + kstep;
            PG8_LDB(B0, 0, 0); PG8_SCHED; PG8_LDA(At, 0, 0); PG8_STAGE(PG8_SA(1, 1), a1 + hstepA, voffA);
            PG8_WAIT_L(8); PG8_BAR; PG8_WAIT_L(0); PG8_MMA(0, 0, At, B0); PG8_BAR; PG8_SCHED;
            PG8_LDB(B1, 0, 1); PG8_STAGE(PG8_SB(0, 0), b2, voffB);
            PG8_BAR; PG8_WAIT_L(0); PG8_MMA(0, 1, At, B1); PG8_BAR;
            PG8_LDA(At, 0, 1); PG8_STAGE(PG8_SA(0, 0), a2, voffA);
            PG8_BAR; PG8_WAIT_L(0); PG8_MMA(1, 0, At, B0); PG8_BAR; PG8_SCHED;
            PG8_STAGE(PG8_SB(0, 1), b2 + hstepB, voffB);
            PG8_WAIT_V(6); PG8_BAR; PG8_MMA(1, 1, At, B1); PG8_BAR;
            PG8_LDB(B0, 1, 0); PG8_SCHED; PG8_LDA(At, 1, 0); PG8_STAGE(PG8_SA(0, 1), a2 + hstepA, voffA);
            PG8_WAIT_L(8); PG8_BAR; PG8_WAIT_L(0); PG8_MMA(0, 0, At, B0); PG8_BAR; PG8_SCHED;
            PG8_LDB(B1, 1, 1); PG8_STAGE(PG8_SB(1, 0), b3, voffB);
            PG8_BAR; PG8_WAIT_L(0); PG8_MMA(0, 1, At, B1); PG8_BAR;
            PG8_LDA(At, 1, 1); PG8_STAGE(PG8_SA(1, 0), a3, voffA);
            PG8_BAR; PG8_WAIT_L(0); PG8_MMA(1, 0, At, B0); PG8_BAR; PG8_SCHED;
            PG8_STAGE(PG8_SB(1, 1), b3 + hstepB, voffB);
            PG8_WAIT_V(6); PG8_BAR; PG8_MMA(1, 1, At, B1); PG8_BAR;
        }
        E(acc, cur, wr, wc, fr, fq);
        if (!has_next) break;
#pragma unroll
        for (int a = 0; a < 2; ++a)
#pragma unroll
            for (int b = 0; b < 2; ++b)
#pragma unroll
                for (int m = 0; m < 4; ++m)
#pragma unroll
                    for (int n = 0; n < 2; ++n) acc[a][b][m][n] = (f32x4){0.f, 0.f, 0.f, 0.f};
        cur = nxt; cA = nA; cB = nB; ++ui;
    }
    PG8_WAIT_V(0);
    if (wr == 0) PG8_BAR;
    PG8_BAR;
#undef PG8_SA
#undef PG8_SB
#undef PG8_STAGE
#undef PG8_LDA
#undef PG8_LDB
#undef PG8_MMA
#undef PG8_WAIT_V
#undef PG8_WAIT_L
#undef PG8_BAR
#undef PG8_SCHED
}

__device__ __forceinline__ u32x4 pk2x4(const f32x4 v0, const f32x4 v1) { u32x4 w; w.x = cvt_pk_bf16(v0[0], v0[1]); w.y = cvt_pk_bf16(v0[2], v0[3]); w.z = cvt_pk_bf16(v1[0], v1[1]); w.w = cvt_pk_bf16(v1[2], v1[3]); return w; }

struct EpiMain {
    static constexpr bool PERM = true;
    bf16_t *Ub, *BGb, *UPb, *Qb, *Kb, *Vb; const f32x4* rope; bf16_t* GS; const float* RS;
    __device__ __forceinline__ void operator()(const Acc& acc, const Unit& u, int wr, int wc, int fr, int fq) const {
        const int row0 = u.pm * BM + wr * 64 + fr, pn = u.pn;
        float rs[2][4];
#pragma unroll
        for (int ai = 0; ai < 2; ++ai)
#pragma unroll
            for (int m = 0; m < 4; ++m) rs[ai][m] = RS[row0 + ai * HALF + m * 16];
        if (pn < 8) {
#pragma unroll
            for (int ai = 0; ai < 2; ++ai)
#pragma unroll
                for (int m = 0; m < 4; ++m) { const size_t row = row0 + ai * HALF + m * 16;
                    st16(Ub + row * 1024 + pn * 128 + wc * 32 + fq * 8, pk2x4(acc[ai][0][m][0] * acc[ai][1][m][0] * (rs[ai][m] * rs[ai][m]), acc[ai][0][m][1] * acc[ai][1][m][1] * (rs[ai][m] * rs[ai][m]))); __builtin_amdgcn_sched_barrier(0); }
        } else if (pn < 16) {
            bf16_t* base = (pn < 12 ? BGb : UPb) + (pn & 3) * 256 + wc * 32 + fq * 8;
#pragma unroll
            for (int ai = 0; ai < 2; ++ai)
#pragma unroll
                for (int m = 0; m < 4; ++m) { const size_t row = row0 + ai * HALF + m * 16;
#pragma unroll
                    for (int bj = 0; bj < 2; ++bj) st16(base + row * 1024 + bj * HALF, pk2x4(acc[ai][bj][m][0] * rs[ai][m], acc[ai][bj][m][1] * rs[ai][m])); __builtin_amdgcn_sched_barrier(0); }
        } else if (pn < 21) {
            const bool isq = pn < 20; const int ld = isq ? 1024 : 256; const float sc = isq ? 0.125f * 1.4426950408889634f : 1.0f;
            bf16_t* base = (isq ? Qb + (pn - 16) * 256 : Kb) + wc * 64 + fq * 8;
#pragma unroll
            for (int am = 0; am < 4; ++am) { const int ai = am >> 1, mh = (am & 1) * 2;
                f32x4 cs[2][4];
#pragma unroll
                for (int mm = 0; mm < 2; ++mm) { const int row = row0 + ai * HALF + (mh + mm) * 16; const int pos = row < MPR ? (row & (TSEQ - 1)) : TSEQ;
                    const f32x4* rp = rope + (size_t)pos * 16 + fq * 4;
#pragma unroll
                    for (int q = 0; q < 4; ++q) cs[mm][q] = rp[q]; }
                __builtin_amdgcn_sched_barrier(0);
#pragma unroll
                for (int mm = 0; mm < 2; ++mm) { const int m = mh + mm; const int row = row0 + ai * HALF + m * 16;
                    f32x4 o1[2], o2[2];
#pragma unroll
                    for (int n = 0; n < 2; ++n) { const f32x4 cs0 = cs[mm][2 * n], cs1 = cs[mm][2 * n + 1]; const f32x4 x1 = acc[ai][0][m][n], x2 = acc[ai][1][m][n];
                        const float scr = sc * rs[ai][m]; const f32x4 c = (f32x4){cs0[0], cs0[2], cs1[0], cs1[2]} * scr, s = (f32x4){cs0[1], cs0[3], cs1[1], cs1[3]} * scr;
                        o1[n] = x1 * c - x2 * s; o2[n] = x2 * c + x1 * s; }
                    st16(base + (size_t)row * ld, pk2x4(o1[0], o1[1])); st16(base + (size_t)row * ld + 32, pk2x4(o2[0], o2[1])); __builtin_amdgcn_sched_barrier(0); }
            }
        } else if (pn == 21) {
            bf16_t* base = Vb + wc * 32 + fq * 8;
#pragma unroll
            for (int ai = 0; ai < 2; ++ai)
#pragma unroll
                for (int m = 0; m < 4; ++m) { const size_t row = row0 + ai * HALF + m * 16;
#pragma unroll
                    for (int bj = 0; bj < 2; ++bj) st16(base + row * 256 + bj * HALF, pk2x4(acc[ai][bj][m][0] * rs[ai][m], acc[ai][bj][m][1] * rs[ai][m])); __builtin_amdgcn_sched_barrier(0); }
        } else {
            const int gi = (pn - 22) >> 2; bf16_t* base = GS + (size_t)gi * SIDE + ((pn - 22) & 3) * 256 + wc * 32 + fq * 8;
#pragma unroll
            for (int ai = 0; ai < 2; ++ai)
#pragma unroll
                for (int m = 0; m < 4; ++m) { const size_t rl = (size_t)(row0 - MPR + ai * HALF + m * 16);
#pragma unroll
                    for (int bj = 0; bj < 2; ++bj) { f32x4 v0 = acc[ai][bj][m][0], v1 = acc[ai][bj][m][1];
#pragma unroll
                        for (int j = 0; j < 4; ++j) { v0[j] = sigmoidf_(v0[j] * rs[ai][m]); v1[j] = sigmoidf_(v1[j] * rs[ai][m]); }
                        st16(base + rl * 1024 + bj * HALF, pk2x4(v0, v1)); } __builtin_amdgcn_sched_barrier(0); }
        }
    }
};
template <int ACT> struct EpiAct {
    static constexpr bool PERM = true;
    bf16_t* O; int ldc; const float* RS;
    __device__ __forceinline__ void operator()(const Acc& acc, const Unit& u, int wr, int wc, int fr, int fq) const {
        const int row0 = u.pm * BM + wr * 64 + fr; bf16_t* base = O + u.pn * BM + wc * 32 + fq * 8;
        float rsv[2][4];
#pragma unroll
        for (int ai = 0; ai < 2; ++ai)
#pragma unroll
            for (int m = 0; m < 4; ++m) rsv[ai][m] = RS[row0 + ai * HALF + m * 16];
#pragma unroll
        for (int ai = 0; ai < 2; ++ai)
#pragma unroll
            for (int m = 0; m < 4; ++m) { const size_t row = row0 + ai * HALF + m * 16; const float rs = rsv[ai][m];
#pragma unroll
                for (int bj = 0; bj < 2; ++bj) { f32x4 v0 = acc[ai][bj][m][0], v1 = acc[ai][bj][m][1];
#pragma unroll
                    for (int j = 0; j < 4; ++j) { if (ACT == 0) { v0[j] = sigmoidf_(v0[j] * rs); v1[j] = sigmoidf_(v1[j] * rs); } else { const float a = fmaxf(v0[j] * rs, 0.f), b = fmaxf(v1[j] * rs, 0.f); v0[j] = a * a; v1[j] = b * b; } }
                    st16(base + row * ldc + bj * HALF, pk2x4(v0, v1)); __builtin_amdgcn_sched_barrier(0); } }
    }
};
struct EpiGate {
    static constexpr bool PERM = true;
    bf16_t* MG; const bf16_t* SG; bool accum; const bf16_t* GS; bf16_t* MS; int g0, g1;
    __device__ __forceinline__ void operator()(const Acc& acc, const Unit& u, int wr, int wc, int fr, int fq) const {
        const bool smp = u.tag >= 0; const int gi = u.tag == 0 ? g0 : g1;
        const int row0 = (smp ? 0 : u.pm * BM) + wr * 64 + fr, col0 = u.pn * BM + wc * 32 + fq * 8;
        const bf16_t* sgb = smp ? GS + (size_t)gi * SIDE : SG; bf16_t* mgb = smp ? MS + (size_t)gi * SIDE : MG; const bool acc_on = accum && !smp;
#pragma unroll
        for (int ai = 0; ai < 2; ++ai) {
            u32x4 sgv[4][2], mgv[4][2];
#pragma unroll
            for (int m = 0; m < 4; ++m)
#pragma unroll
                for (int bj = 0; bj < 2; ++bj) { const size_t off = (size_t)(row0 + ai * HALF + m * 16) * 1024 + col0 + bj * HALF;
                    sgv[m][bj] = *(const u32x4*)(sgb + off); mgv[m][bj] = acc_on ? *(const u32x4*)(mgb + off) : (u32x4){0u, 0u, 0u, 0u}; }
            __builtin_amdgcn_sched_barrier(0);
#pragma unroll
            for (int m = 0; m < 4; ++m) {
#pragma unroll
                for (int bj = 0; bj < 2; ++bj) { const size_t off = (size_t)(row0 + ai * HALF + m * 16) * 1024 + col0 + bj * HALF;
                    float sg[8], mg[8]; unpack8(sgv[m][bj], sg); unpack8(mgv[m][bj], mg);
                    const f32x4 a0 = acc[ai][bj][m][0], a1 = acc[ai][bj][m][1];
#pragma unroll
                    for (int j = 0; j < 4; ++j) { mg[j] += sg[j] * a0[j]; mg[4 + j] += sg[4 + j] * a1[j]; }
                    st16(mgb + off, pack8(mg)); }
                __builtin_amdgcn_sched_barrier(0); }
        }
    }
};
struct EpiOut {
    static constexpr bool PERM = true;
    bf16_t* C; float* CS;
    __device__ __forceinline__ void operator()(const Acc& acc, const Unit& u, int wr, int wc, int fr, int fq) const {
        const bool smp = u.tag >= 0;
        const int row0 = (smp ? 0 : u.pm * BM) + wr * 64 + fr, col0 = u.pn * BM + wc * 32 + 8 * fq;
        if (!smp) {
#pragma unroll
            for (int ai = 0; ai < 2; ++ai)
#pragma unroll
                for (int m = 0; m < 4; ++m) { bf16_t* rowp = C + (size_t)(row0 + ai * HALF + m * 16) * 1024 + col0;
#pragma unroll
                    for (int bj = 0; bj < 2; ++bj) st16(rowp + bj * HALF, pk2x4(acc[ai][bj][m][0], acc[ai][bj][m][1])); __builtin_amdgcn_sched_barrier(0); }
        } else { float* cb = CS + (size_t)u.tag * SIDE;
#pragma unroll
            for (int ai = 0; ai < 2; ++ai)
#pragma unroll
                for (int m = 0; m < 4; ++m) { float* rowp = cb + (size_t)(row0 + ai * HALF + m * 16) * 1024 + col0;
#pragma unroll
                    for (int bj = 0; bj < 2; ++bj)
#pragma unroll
                        for (int n = 0; n < 2; ++n) st16(rowp + bj * HALF + n * 4, acc[ai][bj][m][n]); __builtin_amdgcn_sched_barrier(0); }
        }
    }
};

struct EpiF32 {
    static constexpr bool PERM = false;
    float* C; float* CS;
    __device__ __forceinline__ void operator()(const Acc& acc, const Unit& u, int wr, int wc, int fr, int fq) const {
        const bool smp = u.tag >= 0;
        const int row0 = (smp ? 0 : u.pm * BM) + wr * 64 + fr, col0 = u.pn * BM + wc * 32 + 4 * fq;
        float* cb = smp ? CS + (size_t)u.tag * SIDE : C;
#pragma unroll
        for (int ai = 0; ai < 2; ++ai)
#pragma unroll
            for (int m = 0; m < 4; ++m) { float* rowp = cb + (size_t)(row0 + ai * HALF + m * 16) * 1024 + col0;
#pragma unroll
                for (int bj = 0; bj < 2; ++bj)
#pragma unroll
                    for (int n = 0; n < 2; ++n) st16(rowp + bj * HALF + n * 16, acc[ai][bj][m][n]); __builtin_amdgcn_sched_barrier(0); }
    }
};

__device__ __forceinline__ int win_src_col(int n) {
    const int pn = n >> 8, w = n & 255;
    if (pn < 8) return ((w >> 7) ? 2048 : 0) + pn * 128 + (w & 127);
    if (pn < 12) return 1024 + (pn - 8) * 256 + w;
    if (pn < 16) return n;
    if (pn < 21) { const int base = pn < 20 ? 4096 + (pn - 16) * 256 : 5120; return base + ((w & 127) >> 5) * 64 + (w >> 7) * 32 + (w & 31); }
    return n;
}
__device__ __forceinline__ void convert_job(LAS unsigned char* lds, const float* src, int ld, int K, int N, bf16_t* dst, bool mapped, int& cum, const float* cscale = nullptr, int wg_first = 0, const float* kscale = nullptr) {
    const int tid = opaque_tid(), G = (int)gridDim.x - wg_first, c = (int)blockIdx.x - wg_first;
    const int nkb = K / 128, ntiles = (N / 32) * nkb;
    const int first = (c + G - (cum % G)) % G; cum += ntiles;
    LAS bf16_t* tile = (LAS bf16_t*)lds;
    const int c4 = tid & 7, kr = tid >> 3;
    f32x4 v[2]; f32x4 cs = (f32x4){1.f, 1.f, 1.f, 1.f};
    if (first < ntiles) { const int nb = first / nkb, kb = first % nkb, n0 = nb * 32, k0 = kb * 128; const int sc0 = mapped ? win_src_col(n0) : n0;
#pragma unroll
        for (int i = 0; i < 2; ++i) v[i] = *(const f32x4*)(src + (size_t)(k0 + kr + 64 * i) * ld + sc0 + 4 * c4);
        if (cscale) cs = *(const f32x4*)(cscale + sc0 + 4 * c4); }
    for (int ti = first; ti < ntiles; ti += G) {
        const int nb = ti / nkb, kb = ti % nkb, n0 = nb * 32, k0 = kb * 128;
        __syncthreads();
#pragma unroll
        for (int i = 0; i < 2; ++i) { const int kk = kr + 64 * i; const f32x4 w = v[i] * cs * (kscale ? kscale[k0 + kk] : 1.0f); const unsigned p0 = cvt_pk_bf16(w[0], w[1]), p1 = cvt_pk_bf16(w[2], w[3]);
            tile[(4 * c4 + 0) * 136 + kk] = (bf16_t)(p0 & 0xffff); tile[(4 * c4 + 1) * 136 + kk] = (bf16_t)(p0 >> 16);
            tile[(4 * c4 + 2) * 136 + kk] = (bf16_t)(p1 & 0xffff); tile[(4 * c4 + 3) * 136 + kk] = (bf16_t)(p1 >> 16); }
        __syncthreads();
        const int tn = ti + G;
        if (tn < ntiles) { const int nb2 = tn / nkb, kb2 = tn % nkb, n02 = nb2 * 32, k02 = kb2 * 128; const int sc2 = mapped ? win_src_col(n02) : n02;
#pragma unroll
            for (int i = 0; i < 2; ++i) v[i] = *(const f32x4*)(src + (size_t)(k02 + kr + 64 * i) * ld + sc2 + 4 * c4);
            if (cscale) cs = *(const f32x4*)(cscale + sc2 + 4 * c4); }
        const int n = tid >> 4, kk = (tid & 15) * 8;
        *(u32x4*)(dst + (size_t)(n0 + n) * K + k0 + kk) = *(const LAS u32x4*)(tile + n * 136 + kk);
    }
}
__device__ __forceinline__ void convert_layer(LAS unsigned char* lds, PP p, int l, int parts = 3, int wg_first = 0) {
    if ((int)blockIdx.x < wg_first) return;
    unsigned char* ws = p->ws; OPQ_S(ws); bf16_t* W = (bf16_t*)(ws + WS_W); int cum = 0;
    if (parts & 1) {
        convert_job(lds, p->in[6] + (size_t)l * 1024 * NPROJ, NPROJ, 1024, NPROJ, W + WO_IN, true, cum, nullptr, wg_first, p->in[14] + l * 1024);
        convert_job(lds, p->in[8] + (size_t)l * 1024 * 1024, 1024, 1024, 1024, W + WO_CO, false, cum, nullptr, wg_first);
        for (int g = 0; g < 4; ++g) convert_job(lds, p->in[9] + (size_t)l * 262144 + g * 65536, 256, 256, 256, W + WO_POOL + g * 65536, false, cum, p->in[10] + l * 1024 + g * 256, wg_first);
        convert_job(lds, p->in[12] + (size_t)l * 1024 * 1024, 1024, 1024, 1024, W + WO_AO, false, cum, nullptr, wg_first);
        convert_job(lds, p->in[13] + (size_t)l * 1024 * 1024, 1024, 1024, 1024, W + WO_MIX, false, cum, nullptr, wg_first);
    }
    if (parts & 2) {
        convert_job(lds, p->in[18] + (size_t)l * 1024 * DFF, DFF, 1024, DFF, W + WO_UP, false, cum, nullptr, wg_first, p->in[16] + l * 1024);
        convert_job(lds, p->in[19] + (size_t)l * DFF * 1024, 1024, DFF, 1024, W + WO_DN, false, cum, nullptr, wg_first);
    }
}

__device__ __forceinline__ void row_phase(const float* xin_p, const float* xin_s, const bf16_t* xin_b, float* xout_p, float* xout_s, bf16_t* xout_b, const bf16_t* Y, const float* g_post,
                                          float* RSout, const float* Ypart, int nparts, int r_lo, int r_hi, int wg_first) {
    const int tid_ = opaque_tid(); const int lane = tid_ & 63, wid = tid_ >> 6;
    constexpr int RPW = 4;
    if ((int)blockIdx.x < wg_first) return;
    for (int row0 = r_lo + (((int)blockIdx.x - wg_first) * 8 + wid) * RPW; row0 < r_hi; row0 += ((int)gridDim.x - wg_first) * 8 * RPW) {
        f32x4 x[RPW][4], y[RPW][4];
#pragma unroll
        for (int j = 0; j < RPW; ++j) { const int row = row0 + j;
            if (xin_b) {
#pragma unroll
                for (int i = 0; i < 4; ++i) { const u32x2 w = *(const u32x2*)(xin_b + (size_t)row * 1024 + i * 256 + lane * 4); x[j][i] = (f32x4){bf_lo(w.x), bf_hi(w.x), bf_lo(w.y), bf_hi(w.y)}; }
            } else { const float* xi = row < MPR ? xin_p + (size_t)row * 1024 : xin_s + (size_t)(row - MPR) * 1024;
#pragma unroll
                for (int i = 0; i < 4; ++i) x[j][i] = *(const f32x4*)(xi + i * 256 + lane * 4); } }
        if (Y) {
#pragma unroll
            for (int j = 0; j < RPW; ++j)
#pragma unroll
                for (int i = 0; i < 4; ++i) { const u32x2 w = *(const u32x2*)(Y + (size_t)(row0 + j) * 1024 + i * 256 + lane * 4); y[j][i] = (f32x4){bf_lo(w.x), bf_hi(w.x), bf_lo(w.y), bf_hi(w.y)}; }
            if (row0 >= MPR && Ypart) {
#pragma unroll
                for (int j = 0; j < RPW; ++j)
#pragma unroll
                    for (int i = 0; i < 4; ++i) y[j][i] = *(const f32x4*)(Ypart + (size_t)(row0 - MPR + j) * 1024 + i * 256 + lane * 4);
                for (int k = 1; k < nparts; ++k)
#pragma unroll
                    for (int j = 0; j < RPW; ++j)
#pragma unroll
                        for (int i = 0; i < 4; ++i) y[j][i] += *(const f32x4*)(Ypart + (size_t)k * SIDE + (size_t)(row0 - MPR + j) * 1024 + i * 256 + lane * 4);
            }
            f32x4 g[4];
#pragma unroll
            for (int i = 0; i < 4; ++i) g[i] = *(const f32x4*)(g_post + i * 256 + lane * 4);
#pragma unroll
            for (int j = 0; j < RPW; ++j) { float ss = 0.f;
#pragma unroll
                for (int i = 0; i < 4; ++i) ss += y[j][i][0] * y[j][i][0] + y[j][i][1] * y[j][i][1] + y[j][i][2] * y[j][i][2] + y[j][i][3] * y[j][i][3];
                ss = wave_sum(ss); const float rstd = rsqrtf(ss * (1.0f / 1024.0f) + RMS_EPS);
#pragma unroll
                for (int i = 0; i < 4; ++i) x[j][i] += y[j][i] * rstd * g[i]; }
        }
#pragma unroll
        for (int j = 0; j < RPW; ++j) { const int row = row0 + j;
            if (xout_b) {
#pragma unroll
                for (int i = 0; i < 4; ++i) { u32x2 w; w.x = cvt_pk_bf16(x[j][i][0], x[j][i][1]); w.y = cvt_pk_bf16(x[j][i][2], x[j][i][3]);
                    st8(xout_b + (size_t)row * 1024 + i * 256 + lane * 4, w);
                    x[j][i] = (f32x4){bf_lo(w.x), bf_hi(w.x), bf_lo(w.y), bf_hi(w.y)}; }
            } else if (xout_p) { float* xo = row < MPR ? xout_p + (size_t)row * 1024 : xout_s + (size_t)(row - MPR) * 1024;
#pragma unroll
                for (int i = 0; i < 4; ++i) *(f32x4*)(xo + i * 256 + lane * 4) = x[j][i]; }
            if (RSout) { float ss = 0.f;
#pragma unroll
                for (int i = 0; i < 4; ++i) ss += x[j][i][0] * x[j][i][0] + x[j][i][1] * x[j][i][1] + x[j][i][2] * x[j][i][2] + x[j][i][3] * x[j][i][3];
                ss = wave_sum(ss); if (lane == 0) RSout[row] = rsqrtf(ss * (1.0f / 1024.0f) + RMS_EPS); }
        }
    }
}

__device__ __forceinline__ void rope_table(f32x2* tab) {
    for (int i = blockIdx.x * 512 + opaque_tid(); i < 8193 * 32; i += gridDim.x * 512) {
        const int pos = i >> 5, d = i & 31; const float fpos = pos == 8192 ? 16384.0f : (float)pos;
        const float inv = powf(10000.0f, -(float)d / 32.0f); const float ang = fpos * inv;
        float s, c; sincosf(ang, &s, &c); tab[i] = (f32x2){c, s};
    }
}

struct AttnKV { u32x4 k[4]; u32x4 va[2], vb[2]; bf16x8 q[2][2]; };
__device__ __forceinline__ void attn_load_kv(int tid, int item, const bf16_t* Kb, const bf16_t* Vb, const bf16_t* Qb, AttnKV& r) {
    const int kvh = item & 3, qb = (item >> 2) & 63, b = item >> 8; const int rb = b * TSEQ + qb * 128;
    { const int wid = tid >> 6, lane = tid & 63, fr = lane & 15, fq = lane >> 4, hl = wid >> 1, half = wid & 1, head = kvh * 4 + hl;
#pragma unroll
      for (int qt = 0; qt < 2; ++qt) { const bf16_t* qrow = Qb + (size_t)(rb + half * 64 + qt * 16 + fr) * 1024 + head * 64 + fq * 8; r.q[qt][0] = *(const bf16x8*)qrow; r.q[qt][1] = *(const bf16x8*)(qrow + 32); } }
#pragma unroll
    for (int i = 0; i < 4; ++i) { const int id = tid + 512 * i, j = id >> 3, c8 = id & 7; const long tok = (long)rb - 128 + j;
        r.k[i] = (qb > 0 || j >= 128) ? *(const u32x4*)(Kb + tok * 256 + kvh * 64 + c8 * 8) : (u32x4){0u, 0u, 0u, 0u}; }
#pragma unroll
    for (int i = 0; i < 2; ++i) { const int id = tid + 512 * i, jp = id >> 3, c8 = id & 7; const long tok = (long)rb - 128 + 2 * jp;
        if (qb > 0 || jp >= 64) { r.va[i] = *(const u32x4*)(Vb + tok * 256 + kvh * 64 + c8 * 8); r.vb[i] = *(const u32x4*)(Vb + (tok + 1) * 256 + kvh * 64 + c8 * 8); }
        else { r.va[i] = (u32x4){0u, 0u, 0u, 0u}; r.vb[i] = (u32x4){0u, 0u, 0u, 0u}; } }
}
__device__ __forceinline__ void attn_store_kv(LAS unsigned char* lds, int tid, const AttnKV& r) {
    LAS bf16_t* Ks = (LAS bf16_t*)lds;
    LAS bf16_t* Vt = (LAS bf16_t*)(lds + 36864);
#pragma unroll
    for (int i = 0; i < 4; ++i) { const int id = tid + 512 * i, j = id >> 3, c8 = id & 7; *(LAS u32x4*)(Ks + j * 72 + c8 * 8) = r.k[i]; }
#pragma unroll
    for (int i = 0; i < 2; ++i) { const int id = tid + 512 * i, jp = id >> 3, c8 = id & 7; LAS unsigned* vp = (LAS unsigned*)(Vt + (c8 * 8) * 264 + 2 * jp);
        const u32x4 a = r.va[i], bq = r.vb[i];
        vp[0 * 132] = (a.x & 0xffffu) | (bq.x << 16); vp[1 * 132] = (a.x >> 16) | (bq.x & 0xffff0000u);
        vp[2 * 132] = (a.y & 0xffffu) | (bq.y << 16); vp[3 * 132] = (a.y >> 16) | (bq.y & 0xffff0000u);
        vp[4 * 132] = (a.z & 0xffffu) | (bq.z << 16); vp[5 * 132] = (a.z >> 16) | (bq.z & 0xffff0000u);
        vp[6 * 132] = (a.w & 0xffffu) | (bq.w << 16); vp[7 * 132] = (a.w >> 16) | (bq.w & 0xffff0000u); }
}
__device__ __forceinline__ void attn_prompt_compute(LAS unsigned char* lds, int item, bf16_t* Qb, const bf16x8 (&q01)[2][2], const float* sinks, bf16_t* Ob) {
    const int tid = opaque_tid(), wid = tid >> 6, lane = tid & 63, fr = lane & 15, fq = lane >> 4;
    const int kvh = item & 3, qb = (item >> 2) & 63, b = item >> 8;
    const int rb = b * TSEQ + qb * 128;
    LAS bf16_t* Ks = (LAS bf16_t*)lds;
    LAS bf16_t* Vt = (LAS bf16_t*)(lds + 36864);
    const int hl = wid >> 1, half = wid & 1, head = kvh * 4 + hl;
    const float sink = sinks[head] * 1.4426950408889634f;
    bf16x8 qf[4][2];
    qf[0][0] = q01[0][0]; qf[0][1] = q01[0][1]; qf[1][0] = q01[1][0]; qf[1][1] = q01[1][1];
#pragma unroll
    for (int qt = 2; qt < 4; ++qt) { const bf16_t* qrow = Qb + (size_t)(rb + half * 64 + qt * 16 + fr) * 1024 + head * 64 + fq * 8; qf[qt][0] = *(const bf16x8*)qrow; qf[qt][1] = *(const bf16x8*)(qrow + 32); }
#pragma unroll
    for (int qp = 0; qp < 2; ++qp) {
        const int i0p = half * 64 + qp * 32;
        const int js = min(i0p, 96);
        f32x4 S[2][10];
        __builtin_amdgcn_s_setprio(1);
#pragma unroll
        for (int kt = 0; kt < 10; ++kt) {
            const LAS bf16_t* kp = Ks + (js + kt * 16 + fr) * 72 + fq * 8;
            const bf16x8 k0 = *(const LAS bf16x8*)kp, k1 = *(const LAS bf16x8*)(kp + 32);
#pragma unroll
            for (int u = 0; u < 2; ++u) { f32x4 sv = (f32x4){0.f, 0.f, 0.f, 0.f};
                sv = __builtin_amdgcn_mfma_f32_16x16x32_bf16(k0, qf[2 * qp + u][0], sv, 0, 0, 0);
                sv = __builtin_amdgcn_mfma_f32_16x16x32_bf16(k1, qf[2 * qp + u][1], sv, 0, 0, 0);
                S[u][kt] = sv; }
        }
        __builtin_amdgcn_s_setprio(0);
        float mx[2], rden[2];
#pragma unroll
        for (int u = 0; u < 2; ++u) { const int i0 = i0p + 16 * u, iq = i0 + fr; float m = -1e30f;
#pragma unroll
            for (int kt = 0; kt < 10; ++kt) { const int jb = js + kt * 16;
                const bool interior = (jb >= i0 + 16) && (jb <= i0 + 113) && (qb > 0 || jb >= 128);
                if (interior) {
#pragma unroll
                    for (int r = 0; r < 4; ++r) m = fmaxf(m, S[u][kt][r]);
                } else {
#pragma unroll
                    for (int r = 0; r < 4; ++r) { const int j = jb + fq * 4 + r; const int dlt = j - iq;
                        const bool ok = (dlt >= 1) && (dlt <= 128) && (qb > 0 || j >= 128);
                        const float v = ok ? S[u][kt][r] : -1e30f; S[u][kt][r] = v; m = fmaxf(m, v); } } }
            mx[u] = m; }
#pragma unroll
        for (int u = 0; u < 2; ++u) { float m = mx[u]; m = fmaxf(m, __shfl_xor(m, 16)); m = fmaxf(m, __shfl_xor(m, 32)); mx[u] = fmaxf(m, sink); }
#pragma unroll
        for (int u = 0; u < 2; ++u) { float sum = 0.f;
#pragma unroll
            for (int kt = 0; kt < 10; ++kt)
#pragma unroll
                for (int r = 0; r < 4; ++r) { const float e = __builtin_amdgcn_exp2f(S[u][kt][r] - mx[u]); S[u][kt][r] = e; sum += e; }
            rden[u] = sum; }
#pragma unroll
        for (int u = 0; u < 2; ++u) { float sum = rden[u]; sum += __shfl_xor(sum, 16); sum += __shfl_xor(sum, 32); rden[u] = 1.0f / (sum + __builtin_amdgcn_exp2f(sink - mx[u])); }
        f32x4 O[2][4];
#pragma unroll
        for (int u = 0; u < 2; ++u)
#pragma unroll
            for (int dt = 0; dt < 4; ++dt) O[u][dt] = (f32x4){0.f, 0.f, 0.f, 0.f};
        __builtin_amdgcn_s_setprio(1);
#pragma unroll
        for (int kp = 0; kp < 5; ++kp) {
            bf16x8 pf[2];
#pragma unroll
            for (int u = 0; u < 2; ++u) { u32x4 pw; pw.x = cvt_pk_bf16(S[u][2 * kp][0], S[u][2 * kp][1]); pw.y = cvt_pk_bf16(S[u][2 * kp][2], S[u][2 * kp][3]);
                pw.z = cvt_pk_bf16(S[u][2 * kp + 1][0], S[u][2 * kp + 1][1]); pw.w = cvt_pk_bf16(S[u][2 * kp + 1][2], S[u][2 * kp + 1][3]); pf[u] = __builtin_bit_cast(bf16x8, pw); }
            const int jb0 = js + 32 * kp;
#pragma unroll
            for (int dt = 0; dt < 4; ++dt) {
                const LAS bf16_t* vp = Vt + (dt * 16 + fr) * 264 + jb0 + 4 * fq;
                const u32x2 v0 = *(const LAS u32x2*)vp, v1 = *(const LAS u32x2*)(vp + 16);
                const bf16x8 vf = __builtin_bit_cast(bf16x8, (u32x4){v0.x, v0.y, v1.x, v1.y});
#pragma unroll
                for (int u = 0; u < 2; ++u) O[u][dt] = __builtin_amdgcn_mfma_f32_16x16x32_bf16(pf[u], vf, O[u][dt], 0, 0, 0);
            }
        }
        __builtin_amdgcn_s_setprio(0);
        LAS bf16_t* Os = (LAS bf16_t*)(lds + 70656 + wid * 2304);
#pragma unroll
        for (int u = 0; u < 2; ++u) { const int i0 = i0p + 16 * u;
            float rd[4];
#pragma unroll
            for (int r = 0; r < 4; ++r) rd[r] = __shfl(rden[u], 4 * fq + r);
#pragma unroll
            for (int dt = 0; dt < 4; ++dt)
#pragma unroll
                for (int r = 0; r < 4; ++r) Os[(4 * fq + r) * 72 + dt * 16 + fr] = (bf16_t)(cvt_pk_bf16(O[u][dt][r] * rd[r], 0.f) & 0xffff);
            { const int orow = lane >> 2, seg = lane & 3; const LAS bf16_t* op = Os + orow * 72 + seg * 16;
              const u32x4 w0 = *(const LAS u32x4*)op, w1 = *(const LAS u32x4*)(op + 8);
              bf16_t* gp = Ob + (size_t)(rb + i0 + orow) * 1024 + head * 64 + seg * 16; st16(gp, w0); st16(gp + 8, w1); }
        }
    }
}

__device__ __forceinline__ int attn_item_of(int j) {
    if (gridDim.x != 256) return j;
    const int b = j >> 8, c = j & 255, xcd = c & 7, idx = c >> 3;
    return (b << 8) | ((xcd * 8 + (idx >> 2)) << 2) | (idx & 3);
}
__device__ __forceinline__ void attn_prompt_all(LAS unsigned char* lds, bf16_t* Qb, const bf16_t* Kb, const bf16_t* Vb, const float* sinks, bf16_t* Ob) {
    const int tid = opaque_tid();
    int it = blockIdx.x; AttnKV r;
    if (it < 1024) attn_load_kv(tid, attn_item_of(it), Kb, Vb, Qb, r);
    while (it < 1024) {
        __syncthreads();
        attn_store_kv(lds, tid, r);
        bf16x8 q01[2][2];
        q01[0][0] = r.q[0][0]; q01[0][1] = r.q[0][1]; q01[1][0] = r.q[1][0]; q01[1][1] = r.q[1][1];
        __syncthreads();
        const int nit = it + (int)gridDim.x;
        if (nit < 1024) attn_load_kv(tid, attn_item_of(nit), Kb, Vb, Qb, r);
        attn_prompt_compute(lds, attn_item_of(it), Qb, q01, sinks, Ob);
        it = nit;
    }
}

__device__ __forceinline__ void attn_sample_item(LAS unsigned char* lds, int item, const bf16_t* Qb, const bf16_t* Kb, const bf16_t* Vb, const float* ck, const float* cv, const float* sinks, bf16_t* Ob) {
    const int tid = opaque_tid(), lane = tid & 63, wid = tid >> 6;
    const int b = item >> 1, hh = item & 1;
    LAS float* qs = (LAS float*)lds;
    LAS float* sc = (LAS float*)(lds + 4096);
    const size_t row = (size_t)MPR + b;
    __syncthreads();
    if (tid < 256) { const unsigned w = *(const unsigned*)(Qb + row * 1024 + hh * 512 + tid * 2); qs[tid * 2] = bf_lo(w); qs[tid * 2 + 1] = bf_hi(w); }
    __syncthreads();
    { const int hl = tid >> 6, cb = tid & 63, h = hh * 8 + hl, kvh = h >> 2;
#pragma unroll
      for (int i = 0; i < 2; ++i) { const int c = cb + 64 * i; float acc = 0.f;
          if (c < 127) { const float* kp = ck + ((size_t)b * 128 + c + 1) * 256 + kvh * 64;
#pragma unroll
              for (int d = 0; d < 64; d += 4) { const f32x4 kv = *(const f32x4*)(kp + d); acc += kv[0] * qs[hl * 64 + d] + kv[1] * qs[hl * 64 + d + 1] + kv[2] * qs[hl * 64 + d + 2] + kv[3] * qs[hl * 64 + d + 3]; }
          } else { const bf16_t* kp = Kb + row * 256 + kvh * 64;
#pragma unroll
              for (int d = 0; d < 64; d += 2) { const unsigned w = *(const unsigned*)(kp + d); acc += bf_lo(w) * qs[hl * 64 + d] + bf_hi(w) * qs[hl * 64 + d + 1]; } }
          sc[hl * 128 + c] = acc; } }
    __syncthreads();
    { const int hl = wid, h = hh * 8 + hl; const float sink = sinks[h] * 1.4426950408889634f;
        const float s0 = sc[hl * 128 + lane], s1 = sc[hl * 128 + lane + 64];
        float mx = fmaxf(s0, s1);
#pragma unroll
        for (int o = 32; o >= 1; o >>= 1) mx = fmaxf(mx, __shfl_xor(mx, o));
        mx = fmaxf(mx, sink);
        const float e0 = __builtin_amdgcn_exp2f(s0 - mx), e1 = __builtin_amdgcn_exp2f(s1 - mx); const float sum = wave_sum(e0 + e1);
        const float rden = 1.0f / (sum + __builtin_amdgcn_exp2f(sink - mx));
        sc[hl * 128 + lane] = e0 * rden; sc[hl * 128 + lane + 64] = e1 * rden; }
    __syncthreads();
    { const int hl = tid >> 6, d = tid & 63, h = hh * 8 + hl, kvh = h >> 2; float o0 = 0.f;
      const float* vp = cv + ((size_t)b * 128 + 1) * 256 + kvh * 64 + d;
      for (int c0 = 0; c0 < 120; c0 += 8) { float v[8];
#pragma unroll
          for (int k = 0; k < 8; ++k) v[k] = vp[(size_t)(c0 + k) * 256];
#pragma unroll
          for (int k = 0; k < 8; ++k) o0 += sc[hl * 128 + c0 + k] * v[k]; }
      { float v[7];
#pragma unroll
          for (int k = 0; k < 7; ++k) v[k] = vp[(size_t)(120 + k) * 256];
#pragma unroll
          for (int k = 0; k < 7; ++k) o0 += sc[hl * 128 + 120 + k] * v[k]; }
      { const unsigned w = *(const unsigned*)(Vb + row * 256 + kvh * 64 + (d & ~1)); o0 += sc[hl * 128 + 127] * ((d & 1) ? bf_hi(w) : bf_lo(w)); }
      const float o1 = __shfl_xor(o0, 1);
      if (!(d & 1)) st4(Ob + row * 1024 + h * 64 + d, cvt_pk_bf16(o0, o1)); }
}

__device__ __forceinline__ void cache_shift_copy(const float* __restrict__ src, float* __restrict__ dst, int wg_first, int b_lo = 0, int b_hi = 128) {
    if ((int)blockIdx.x < wg_first) return;
    const int nthr = ((int)gridDim.x - wg_first) * 512, t0 = ((int)blockIdx.x - wg_first) * 512 + opaque_tid();
    constexpr int PER_B = 127 * 64;
    for (int i = b_lo * PER_B + t0; i < b_hi * PER_B; i += 4 * nthr) {
        f32x4 v[4];
#pragma unroll
        for (int k = 0; k < 4; ++k) { const int ii = i + k * nthr; if (ii < b_hi * PER_B) { const int b = ii / PER_B, r = ii - b * PER_B; v[k] = __builtin_nontemporal_load((const f32x4*)(src + ((size_t)b * 128 + 1) * 256 + (size_t)r * 4)); } }
#pragma unroll
        for (int k = 0; k < 4; ++k) { const int ii = i + k * nthr; if (ii < b_hi * PER_B) { const int b = ii / PER_B, r = ii - b * PER_B; __builtin_nontemporal_store(v[k], (f32x4*)(dst + (size_t)b * 128 * 256 + (size_t)r * 4)); } }
    }
}

__device__ __forceinline__ void store8f(float* o, const float (&f)[8]) { *(f32x4*)o = (f32x4){f[0], f[1], f[2], f[3]}; *(f32x4*)(o + 4) = (f32x4){f[4], f[5], f[6], f[7]}; }
__device__ __forceinline__ void load8f(const float* s, float (&f)[8]) { const f32x4 a = *(const f32x4*)s, b = *(const f32x4*)(s + 4); f[0] = a[0]; f[1] = a[1]; f[2] = a[2]; f[3] = a[3]; f[4] = b[0]; f[5] = b[1]; f[6] = b[2]; f[7] = b[3]; }

__device__ __forceinline__ void mix_elementwise(PP p, int l, const bf16_t* __restrict__ Ub, const bf16_t* BGb, const bf16_t* __restrict__ UPb, bf16_t* __restrict__ PLb, bf16_t* BGo) {
    const size_t gtid = (size_t)blockIdx.x * 512 + opaque_tid(), gstride = (size_t)gridDim.x * 512;
    const float* convw = p->in[7] + (size_t)l * 3 * 1024;
    const float* stc = p->in[2] + (size_t)l * 128 * 2 * 1024; const float* stp = p->in[3] + (size_t)l * 128 * 15 * 1024;
    const size_t gtid_x = (gridDim.x == 256) ? (size_t)(((blockIdx.x & 7u) * 32u + (blockIdx.x >> 3)) * 512u) + (gtid & 511) : gtid;
    for (size_t wi = gtid_x; wi < (size_t)(MPR / 32) * 128; wi += gstride) {
        const int c8 = (int)(wi & 127) * 8, run = (int)(wi >> 7); const int row0 = run * 32, t0 = row0 & (TSEQ - 1);
        const int g = c8 >> 8, win = 2 << g;
        float w0[8], w1[8], w2[8], u0[8], u1[8], s[8];
        load8f(convw + c8, w0); load8f(convw + 1024 + c8, w1); load8f(convw + 2048 + c8, w2);
        const size_t off0 = (size_t)row0 * 1024 + c8;
#pragma unroll
        for (int e = 0; e < 8; ++e) { u0[e] = 0.f; u1[e] = 0.f; s[e] = 0.f; }
        if (t0 > 0) {
            unpack8(*(const u32x4*)(Ub + off0 - 2048), u0); unpack8(*(const u32x4*)(Ub + off0 - 1024), u1);
            for (int k = 1; k <= win; ++k) { float v[8]; unpack8(*(const u32x4*)(UPb + off0 - (size_t)k * 1024), v);
#pragma unroll
                for (int e = 0; e < 8; ++e) s[e] += v[e]; }
        }
        u32x4 ru[4], rb[4], rp[4], ro[4];
#pragma unroll
        for (int k = 0; k < 4; ++k) { const size_t off = off0 + (size_t)k * 1024;
            ru[k] = *(const u32x4*)(Ub + off); rb[k] = *(const u32x4*)(BGb + off); rp[k] = *(const u32x4*)(UPb + off);
            ro[k] = (t0 + k >= win) ? *(const u32x4*)(UPb + off - (size_t)win * 1024) : (u32x4){0u, 0u, 0u, 0u}; }
        for (int j4 = 0; j4 < 32; j4 += 4) {
#pragma unroll
            for (int k = 0; k < 4; ++k) {
                const int j = j4 + k; const size_t off = off0 + (size_t)j * 1024; const int t = t0 + j;
                float u2[8], bg[8], up[8], o[8], old[8];
                unpack8(ru[k], u2); unpack8(rb[k], bg); unpack8(rp[k], up); unpack8(ro[k], old);
                if (j4 < 28) {
                    ru[k] = *(const u32x4*)(Ub + off + 4096); rb[k] = *(const u32x4*)(BGb + off + 4096); rp[k] = *(const u32x4*)(UPb + off + 4096);
                    ro[k] = (t + 4 >= win) ? *(const u32x4*)(UPb + off + 4096 - (size_t)win * 1024) : (u32x4){0u, 0u, 0u, 0u}; }
                const float rcnt = 1.0f / (float)min(win, t + 1);
#pragma unroll
                for (int e = 0; e < 8; ++e) { s[e] += up[e] - old[e]; o[e] = bg[e] * (w0[e] * u0[e] + w1[e] * u1[e] + w2[e] * u2[e]); u0[e] = u1[e]; u1[e] = u2[e]; }
                st16(BGo + off, pack8(o));
#pragma unroll
                for (int e = 0; e < 8; ++e) o[e] = s[e] * rcnt - up[e];
                st16(PLb + off, pack8(o));
            }
        }
    }
    for (size_t i = gtid; i < (size_t)NS * 128; i += gstride) {
        const int b = (int)(i >> 7), c8 = (int)(i & 127) * 8; const size_t off = ((size_t)MPR + b) * 1024 + c8;
        float w0[8], w1[8], w2[8], u0[8], u1[8], u2[8], bg[8], up[8], s[8], o[8];
        load8f(convw + c8, w0); load8f(convw + 1024 + c8, w1); load8f(convw + 2048 + c8, w2);
        unpack8(*(const u32x4*)(Ub + off), u2); unpack8(*(const u32x4*)(BGb + off), bg); unpack8(*(const u32x4*)(UPb + off), up);
        const int g = c8 >> 8, win = 2 << g;
#pragma unroll
        for (int e = 0; e < 8; ++e) s[e] = up[e];
        load8f(stc + (size_t)(b * 2 + 0) * 1024 + c8, u0); load8f(stc + (size_t)(b * 2 + 1) * 1024 + c8, u1);
        for (int k = 1; k < win; ++k) { float v[8]; load8f(stp + (size_t)(b * 15 + 15 - k) * 1024 + c8, v);
#pragma unroll
            for (int e = 0; e < 8; ++e) s[e] += v[e]; }
        const float rcnt = 1.0f / (float)win;
#pragma unroll
        for (int e = 0; e < 8; ++e) o[e] = bg[e] * (w0[e] * u0[e] + w1[e] * u1[e] + w2[e] * u2[e]);
        st16(BGo + off, pack8(o));
#pragma unroll
        for (int e = 0; e < 8; ++e) o[e] = s[e] * rcnt - up[e];
        st16(PLb + off, pack8(o));
    }
}
__device__ __forceinline__ void state_outputs(PP p, int l, const bf16_t* Ub, const bf16_t* UPb, const bf16_t* Kb, const bf16_t* Vb) {
    const size_t gtid = (size_t)blockIdx.x * 512 + opaque_tid(), gstride = (size_t)gridDim.x * 512;
    const float* stc = p->in[2] + (size_t)l * 128 * 2 * 1024; const float* stp = p->in[3] + (size_t)l * 128 * 15 * 1024;
    float* out = p->out; float f[8];
    for (size_t i = gtid; i < 4 * 2 * 128; i += gstride) { const int b = (int)(i >> 8), r = (int)(i >> 7) & 1, c8 = (int)(i & 127) * 8;
        unpack8(*(const u32x4*)(Ub + ((size_t)b * TSEQ + TSEQ - 2 + r) * 1024 + c8), f); store8f(out + O_PC + (size_t)l * 8192 + (b * 2 + r) * 1024 + c8, f); }
    for (size_t i = gtid; i < 4 * 15 * 128; i += gstride) { const int b = (int)(i / 1920), r = (int)(i >> 7) % 15, c8 = (int)(i & 127) * 8;
        unpack8(*(const u32x4*)(UPb + ((size_t)b * TSEQ + TSEQ - 15 + r) * 1024 + c8), f); store8f(out + O_PP + (size_t)l * 61440 + (b * 15 + r) * 1024 + c8, f); }
    for (size_t i = gtid; i < 4 * 128 * 32; i += gstride) { const int b = (int)(i >> 12), sidx = (int)(i >> 5) & 127, c8 = (int)(i & 31) * 8; const size_t so = ((size_t)b * TSEQ + TSEQ - 128 + sidx) * 256 + c8, oo = (size_t)l * 131072 + (b * 128 + sidx) * 256 + c8;
        unpack8(*(const u32x4*)(Kb + so), f); store8f(out + O_PK + oo, f); unpack8(*(const u32x4*)(Vb + so), f); store8f(out + O_PV + oo, f); }
    for (size_t i = gtid; i < 128 * 2 * 128; i += gstride) { const int b = (int)(i >> 8), r = (int)(i >> 7) & 1, c8 = (int)(i & 127) * 8;
        if (r == 0) load8f(stc + (size_t)(b * 2 + 1) * 1024 + c8, f); else unpack8(*(const u32x4*)(Ub + ((size_t)MPR + b) * 1024 + c8), f);
        store8f(out + O_SC + (size_t)l * 262144 + (b * 2 + r) * 1024 + c8, f); }
    for (size_t i = gtid; i < 128 * 15 * 128; i += gstride) { const int b = (int)(i / 1920), r = (int)(i >> 7) % 15, c8 = (int)(i & 127) * 8;
        if (r < 14) load8f(stp + (size_t)(b * 15 + r + 1) * 1024 + c8, f); else unpack8(*(const u32x4*)(UPb + ((size_t)MPR + b) * 1024 + c8), f);
        store8f(out + O_SP + (size_t)l * 1966080 + (b * 15 + r) * 1024 + c8, f); }
    for (size_t i = gtid; i < (size_t)128 * 32; i += gstride) { const int b = (int)(i >> 5), c8 = (int)(i & 31) * 8; const size_t oo = (size_t)l * 4194304 + ((size_t)b * 128 + 127) * 256 + c8;
        unpack8(*(const u32x4*)(Kb + ((size_t)MPR + b) * 256 + c8), f); store8f(out + O_SK + oo, f); unpack8(*(const u32x4*)(Vb + ((size_t)MPR + b) * 256 + c8), f); store8f(out + O_SV + oo, f); }
}

#define XB_TMO      128
#define XB_XCNT(j)  (256  + 64 * (j))
#define XB_XSUB(j)  (1280 + 64 * (j))
#define XB_XGEN(j)  (2304 + 64 * (j))
#define XB_TOP      3328
#define XB_TOPGEN   3392
#define XCD_BAR_WORDS 3456
#define XB_SPIN_CAP (1u << 16)
__device__ __forceinline__ unsigned xb_ld(unsigned* p)              { return __hip_atomic_load(p, __ATOMIC_RELAXED, __HIP_MEMORY_SCOPE_AGENT); }
__device__ __forceinline__ unsigned xb_add(unsigned* p, unsigned v) { return __hip_atomic_fetch_add(p, v, __ATOMIC_RELAXED, __HIP_MEMORY_SCOPE_AGENT); }
__device__ __forceinline__ unsigned xb_xcc_id() { return (unsigned)__builtin_amdgcn_s_getreg((3 << 11) | 20) & 0xFu; }
#define XB_SPIN(cond, bar) do { unsigned _sp = 0; while (cond) { __builtin_amdgcn_s_sleep(8); \
    if ((++_sp & 255u) == 0u) { if (xb_ld(&(bar)[XB_TMO])) break; if (_sp > XB_SPIN_CAP) { atomicAdd(&(bar)[XB_TMO], 1u); break; } } } } while (0)
struct XcdBarrier { unsigned* bar; unsigned x; volatile LAS unsigned* st; };
__device__ __forceinline__ XcdBarrier xcd_barrier_post(unsigned* bar, volatile LAS unsigned* st) {
    XcdBarrier b; b.bar = bar; b.x = xb_xcc_id(); b.st = st;
    if (threadIdx.x == 0) (void)xb_add(&bar[XB_XCNT(b.x)], 1u);
    return b;
}
__device__ __forceinline__ void xcd_barrier_complete(unsigned* bar, unsigned x, unsigned& nloc, unsigned& nx) {
    const unsigned G = gridDim.x * gridDim.y * gridDim.z;
    unsigned sum, cnt, mine, sp = 0u;
    for (;;) {
        sum = 0u; cnt = 0u; mine = 0u;
#pragma unroll
        for (unsigned j = 0; j < 16; ++j) { const unsigned c = xb_ld(&bar[XB_XCNT(j)]); sum += c; cnt += (c > 0u) ? 1u : 0u; mine = (j == x) ? c : mine; }
        if (sum == G) break;
        __builtin_amdgcn_s_sleep(1);
        if ((++sp & 255u) == 0u) { if (xb_ld(&bar[XB_TMO])) break; if (sp > XB_SPIN_CAP) { atomicAdd(&bar[XB_TMO], 1u); break; } }
    }
    nloc = mine > 0u ? mine : 1u; nx = cnt > 0u ? cnt : 1u;
}
__device__ __forceinline__ void xcd_barrier(const XcdBarrier& b) {
    asm volatile("s_waitcnt vmcnt(0)" ::: "memory");
    __syncthreads();
    if (threadIdx.x == 0) {
        unsigned* bar = b.bar;
        __builtin_amdgcn_s_waitcnt(0);
        unsigned nloc = b.st[0], nx = b.st[1];
        if (nloc == 0u) { xcd_barrier_complete(bar, b.x, nloc, nx); b.st[0] = nloc; b.st[1] = nx; }
        const unsigned old = xb_add(&bar[XB_XSUB(b.x)], 1u);
        const unsigned gen = old / nloc;
        if (old + 1u == (gen + 1u) * nloc) {
            __builtin_amdgcn_fence(__ATOMIC_RELEASE, "agent");
            asm volatile("s_waitcnt vmcnt(0)" ::: "memory");
            const unsigned og = xb_add(&bar[XB_TOP], 1u);
            const unsigned tg = og / nx;
            if (og + 1u == (tg + 1u) * nx) xb_add(&bar[XB_TOPGEN], 1u);
            else XB_SPIN(xb_ld(&bar[XB_TOPGEN]) == tg, bar);
            __builtin_amdgcn_fence(__ATOMIC_ACQUIRE, "agent");
            xb_add(&bar[XB_XGEN(b.x)], 1u);
            asm volatile("s_waitcnt vmcnt(0)" ::: "memory");
        } else {
            XB_SPIN(xb_ld(&bar[XB_XGEN(b.x)]) == gen, bar);
            __builtin_amdgcn_fence(__ATOMIC_ACQUIRE, "agent");
            asm volatile("s_waitcnt vmcnt(0)" ::: "memory");
        }
    }
    __syncthreads();
}

#ifndef PHMASK
#define PHMASK 0xFFFF
#endif
#define PH(n) if (PHMASK & (1 << (n)))
#define WSPTRS() PP p = (PP)__builtin_amdgcn_kernarg_segment_ptr(); OPQ_S(p); unsigned char* ws = p->ws; \
    bf16_t* W = (bf16_t*)(ws + WS_W); bf16_t* Hb = (bf16_t*)(ws + WS_H); \
    bf16_t* R1 = (bf16_t*)(ws + WS_R1); bf16_t* R2 = (bf16_t*)(ws + WS_R2); bf16_t* R3 = (bf16_t*)(ws + WS_R3); bf16_t* R4 = (bf16_t*)(ws + WS_R4); \
    bf16_t* Kb = (bf16_t*)(ws + WS_R5); bf16_t* Vb = Kb + (size_t)MP * 256; bf16_t* PLb = (bf16_t*)(ws + WS_R5 + UNIT); \
    bf16_t* MIXf = (bf16_t*)(ws + WS_R2); bf16_t* Ff = (bf16_t*)(ws + WS_R5); bf16_t* X1b = (bf16_t*)(ws + WS_R5 + UNIT); (void)X1b; f32x2* rope = (f32x2*)(ws + WS_ROPE); \
    float* yp = p->out + O_YP; float* ys = p->out + O_YS; \
    (void)W; (void)Hb; (void)R1; (void)R2; (void)R3; (void)R4; (void)Kb; (void)Vb; (void)PLb; (void)MIXf; (void)Ff; (void)rope; (void)yp; (void)ys

__global__ void __launch_bounds__(512, 2) fwd_megakernel(Params p_unused) {
    extern __shared__ __attribute__((aligned(16))) unsigned char shm[];
    LAS unsigned char* lds = (LAS unsigned char*)shm;
    cg::grid_group grid = cg::this_grid();
    volatile LAS unsigned* xb_st = (volatile LAS unsigned*)(lds + STAGE_BYTES);
    if (threadIdx.x == 0) { xb_st[0] = 0u; xb_st[1] = 0u; }
    __syncthreads();
    const XcdBarrier xb = xcd_barrier_post((unsigned*)(((PP)__builtin_amdgcn_kernarg_segment_ptr())->ws + WS_BAR), xb_st);
#define GRID_SYNC() xcd_barrier(xb)
    if (((PP)__builtin_amdgcn_kernarg_segment_ptr())->out == nullptr) grid.sync();
    PH(0) { WSPTRS(); rope_table(rope); }
    PH(1) { WSPTRS(); convert_layer(lds, p, 0, 1, 0); }
    PH(2) { WSPTRS(); float* RS0 = (float*)(ws + WS_RS); row_phase(p->in[0], p->in[1], nullptr, nullptr, nullptr, Hb, nullptr, nullptr, RS0, nullptr, 0, 0, MREAL, 0); }
    GRID_SYNC();

#define STILE(p, ld) ((const char*)((p) + (size_t)MPR * (ld)))
#define SIDEPTRS() bf16_t* GS = (bf16_t*)(ws + WS_GS); bf16_t* MS = (bf16_t*)(ws + WS_MS); float* MIXP = (float*)(ws + WS_MIXP); float* FP = (float*)(ws + WS_FP); float* RS0 = (float*)(ws + WS_RS); float* RS1 = RS0 + MP; (void)GS; (void)MS; (void)MIXP; (void)FP; (void)RS0; (void)RS1
    for (int l = 0; l < 2; ++l) {
        PH(3) { WSPTRS(); SIDEPTRS(); const bf16_t* XA_ = l == 0 ? (const bf16_t*)Hb : (const bf16_t*)yp;     PhaseOrder S; S.init(XA_, W + WO_IN, 1024, 1024, 0, 22, true);
            S.X = Extra{34, 34, STILE(XA_, 1024), (const char*)(W + WO_IN), 0, 0, 0, (size_t)512 * 1024};
            EpiMain E{R1, R2, R3, R4, Kb, Vb, (const f32x4*)rope, GS, RS0}; gemm_phase(lds, 1024, 1024, 1024, S, E);
            convert_layer(lds, p, l, 2, 34);
            cache_shift_copy(p->in[4], p->out + O_SK, 34, l * 64, l * 64 + 64); }
        GRID_SYNC();
        PH(4) { WSPTRS(); attn_prompt_all(lds, R4, Kb, Vb, p->in[11] + l * 16, R4); }
        PH(5) { WSPTRS(); for (int it = blockIdx.x; it < 256; it += gridDim.x) attn_sample_item(lds, it, R4, Kb, Vb, p->in[4] + (size_t)l * 128 * 128 * 256, p->in[5] + (size_t)l * 128 * 128 * 256, p->in[11] + l * 16, R4); }
        PH(6) { WSPTRS(); mix_elementwise(p, l, R1, R2, R3, PLb, R2); }
        PH(6) { WSPTRS(); state_outputs(p, l, R1, R3, Kb, Vb); }
        GRID_SYNC();
        PH(7) { WSPTRS(); SIDEPTRS(); const bf16_t* XA_ = l == 0 ? (const bf16_t*)Hb : (const bf16_t*)yp;     PhaseOrder S; S.init(XA_, W + WO_IN + (size_t)5632 * 1024, 1024, 1024, 0, 4, true); EpiAct<0> E{R1, 1024, RS0}; gemm_phase(lds, 1024, 1024, 1024, S, E); }
        PH(8) { WSPTRS(); SIDEPTRS(); PhaseOrder S; S.init(R2, W + WO_CO, 1024, 1024, 0, 4, true);
            S.X = Extra{8, 4, STILE(R2, 1024), (const char*)(W + WO_CO), 2 * UNIT, (WO_AO - WO_CO) * 2, 0, (size_t)512 * 1024};
            EpiGate E{R1, R1, false, GS, MS, 0, 2}; gemm_phase(lds, 1024, 1024, 1024, S, E); }
        PH(7) { WSPTRS(); SIDEPTRS(); const bf16_t* XA_ = l == 0 ? (const bf16_t*)Hb : (const bf16_t*)yp;     PhaseOrder S; S.init(XA_, W + WO_IN + (size_t)7680 * 1024, 1024, 1024, 0, 4, true); EpiAct<0> E{R3, 1024, RS0}; gemm_phase(lds, 1024, 1024, 1024, S, E); }
        PH(10) { WSPTRS(); SIDEPTRS(); PhaseOrder S; S.init(R4, W + WO_AO, 1024, 1024, 0, 4, true); EpiGate E{R1, R3, true, GS, MS, 0, 0}; gemm_phase(lds, 1024, 1024, 1024, S, E);
            cache_shift_copy(p->in[5] + (size_t)l * 128 * 128 * 256, p->out + O_SV + (size_t)l * 4194304, 8); }
        PH(7) { WSPTRS(); SIDEPTRS(); const bf16_t* XA_ = l == 0 ? (const bf16_t*)Hb : (const bf16_t*)yp;     PhaseOrder S; S.init(XA_, W + WO_IN + (size_t)6656 * 1024, 1024, 1024, 0, 4, true); EpiAct<0> E{Kb, 1024, RS0};     gemm_phase(lds, 1024, 1024, 1024, S, E); }
        PH(9) { WSPTRS(); SIDEPTRS(); PhaseOrder S; S.init(PLb, W + WO_POOL, 1024, 256, 256, 4, true);
            S.X = Extra{4, 4, STILE(PLb, 1024), (const char*)(W + WO_POOL), 0, 0, 512, (size_t)512 * 256};
            EpiGate E{R1, Kb, true, GS, MS, 1, 1}; int kpool = 256; OPQ_S(kpool); gemm_phase(lds, kpool, 1024, 256, S, E); }
        GRID_SYNC();
        PH(11) { WSPTRS(); SIDEPTRS(); PhaseOrder S; S.init(R1, W + WO_MIX, 1024, 1024, 0, 4, true); EpiOut E{MIXf, MIXP}; gemm_phase(lds, 1024, 1024, 1024, S, E); }
        GRID_SYNC();
        PH(11) { WSPTRS(); SIDEPTRS(); PhaseOrder S; S.init(R1, W + WO_MIX, 1024, 1024, 0, 4, false);
            S.X = Extra{12, 4, (const char*)MS, (const char*)(W + WO_MIX), SIDE * 2, 0, 0, (size_t)512 * 1024};
            EpiOut E{MIXf, MIXP}; gemm_phase(lds, 1024, 1024, 1024, S, E); }
        PH(12) { WSPTRS(); SIDEPTRS(); const bf16_t* XA_ = l == 0 ? (const bf16_t*)Hb : (const bf16_t*)yp;     row_phase(nullptr, nullptr, XA_, nullptr, nullptr, X1b, MIXf, p->in[15] + l * 1024, RS1, MIXP, 3, 0, MPR, 12); }
        GRID_SYNC();
        PH(12) { WSPTRS(); SIDEPTRS(); const bf16_t* XA_ = l == 0 ? (const bf16_t*)Hb : (const bf16_t*)yp;     row_phase(nullptr, nullptr, XA_, nullptr, nullptr, X1b, MIXf, p->in[15] + l * 1024, RS1, MIXP, 3, MPR, MREAL, 0); }
        GRID_SYNC();
        PH(13) { WSPTRS(); SIDEPTRS(); PhaseOrder S; S.init(X1b, W + WO_UP, 1024, 1024, 0, 16, true);
            S.X = Extra{16, 16, STILE(X1b, 1024), (const char*)(W + WO_UP), 0, 0, 0, (size_t)512 * 1024};
            EpiAct<1> E{R1, DFF, RS1}; gemm_phase(lds, 1024, 1024, 1024, S, E);
            if (l == 0) convert_layer(lds, p, 1, 1, 16); else cache_shift_copy(p->in[4] + (size_t)128 * 128 * 256, p->out + O_SK + (size_t)4194304, 16); }
        GRID_SYNC();
        PH(14) { WSPTRS(); SIDEPTRS(); PhaseOrder S; S.init(R1, W + WO_DN, DFF, DFF, 0, 4, true); EpiOut E{Ff, FP}; gemm_phase(lds, DFF, DFF, DFF, S, E); }
        GRID_SYNC();
        PH(14) { WSPTRS(); SIDEPTRS(); PhaseOrder S; S.init(R1, W + WO_DN, DFF, DFF, 0, 4, false);
            S.X = Extra{16, 4, STILE(R1, DFF), (const char*)(W + WO_DN), 2048, 2048, 0, (size_t)512 * DFF};
            EpiOut E{Ff, FP}; gemm_phase(lds, 1024, DFF, DFF, S, E); }
        PH(12) { WSPTRS(); SIDEPTRS(); row_phase(nullptr, nullptr, X1b, l == 0 ? nullptr : yp, l == 0 ? nullptr : ys, l == 0 ? (bf16_t*)yp : nullptr, Ff, p->in[17] + l * 1024, l == 0 ? RS0 : nullptr, FP, 4, 0, MPR, 16); }
        GRID_SYNC();
        PH(12) { WSPTRS(); SIDEPTRS(); row_phase(nullptr, nullptr, X1b, l == 0 ? nullptr : yp, l == 0 ? nullptr : ys, l == 0 ? (bf16_t*)yp : nullptr, Ff, p->in[17] + l * 1024, l == 0 ? RS0 : nullptr, FP, 4, MPR, MREAL, 0); }
        if (l == 0) GRID_SYNC();
    }
}

extern "C" void kernel_launch(void* const* d_in, const int* in_sizes, int n_in, void* d_out, int out_size, void* d_ws, size_t ws_size, hipStream_t stream) {
    constexpr size_t kDynLds = STAGE_BYTES + 64;
    static int grid_blocks = 0;
    if (!grid_blocks) {
        int dev = 0, cus = 0, per_cu = 0;
        hipGetDevice(&dev);
        hipDeviceGetAttribute(&cus, hipDeviceAttributeMultiprocessorCount, dev);
        hipFuncSetAttribute((const void*)fwd_megakernel, hipFuncAttributeMaxDynamicSharedMemorySize, (int)kDynLds);
        hipOccupancyMaxActiveBlocksPerMultiprocessor(&per_cu, (const void*)fwd_megakernel, 512, kDynLds);
        if (per_cu < 1) per_cu = 1;
        grid_blocks = cus * per_cu;
        if (ws_size < WS_END) fprintf(stderr, "kernel_launch: workspace too small: %zu < %zu\n", ws_size, (size_t)WS_END);
    }
    Params p{};
    for (int i = 0; i < 20; ++i) p.in[i] = (const float*)d_in[i];
    p.out = (float*)d_out; p.ws = (unsigned char*)d_ws;
    (void)hipMemsetAsync((char*)d_ws + WS_BAR, 0, 16384, stream);
    void* args[] = {&p};
    hipError_t e = hipLaunchCooperativeKernel((const void*)fwd_megakernel, dim3(grid_blocks), dim3(512), args, kDynLds, stream);
    if (e != hipSuccess) fprintf(stderr, "cooperative launch failed: %s (grid %d)\n", hipGetErrorString(e), grid_blocks);
}
```

```cpp
#include <hip/hip_runtime.h>
#include <hip/hip_cooperative_groups.h>
#include <cstdio>
namespace cg = cooperative_groups;

#define LAS __attribute__((address_space(3)))
typedef unsigned short bf16_t;
typedef short bf16x8 __attribute__((ext_vector_type(8)));
typedef float f32x4 __attribute__((ext_vector_type(4)));
typedef float f32x2 __attribute__((ext_vector_type(2)));
typedef unsigned u32x4 __attribute__((ext_vector_type(4)));
typedef unsigned u32x2 __attribute__((ext_vector_type(2)));

constexpr int DM = 1024, TSEQ = 8192, MPR = 32768, NS = 128, MREAL = MPR + NS, MP = 33024;
constexpr int NPROJ = 8704, DFF = 4096, NMAIN = 5632;
constexpr float RMS_EPS = 1e-6f;
constexpr size_t O_YP = 0, O_YS = O_YP + (size_t)MPR * DM, O_PC = O_YS + (size_t)NS * DM, O_PP = O_PC + 2 * 4 * 2 * 1024,
                 O_PK = O_PP + 2 * 4 * 15 * 1024, O_PV = O_PK + 2 * 4 * 128 * 256, O_SC = O_PV + 2 * 4 * 128 * 256,
                 O_SP = O_SC + 2 * 128 * 2 * 1024, O_SK = O_SP + 2 * 128 * 15 * 1024, O_SV = O_SK + (size_t)2 * 128 * 128 * 256;
constexpr size_t UNIT = (size_t)MP * 1024 * 2;
constexpr size_t WS_ROPE = 4096, ROPE_BYTES = (size_t)8193 * 32 * 8;
constexpr size_t WS_W = WS_ROPE + ((ROPE_BYTES + 4095) / 4096) * 4096;
constexpr size_t WO_IN = 0, WO_CO = WO_IN + (size_t)8704 * 1024, WO_POOL = WO_CO + 1024 * 1024, WO_AO = WO_POOL + 1024 * 256,
                 WO_MIX = WO_AO + 1024 * 1024, WO_UP = WO_MIX + 1024 * 1024, WO_DN = WO_UP + 4096 * 1024, WO_END = WO_DN + 4096 * 1024;
constexpr size_t WS_H = WS_W + ((WO_END * 2 + 4095) / 4096) * 4096;
constexpr size_t WS_R1 = WS_H + UNIT, WS_R2 = WS_R1 + UNIT, WS_R3 = WS_R2 + UNIT, WS_R4 = WS_R3 + UNIT, WS_R5 = WS_R4 + UNIT, WS_GS = WS_R5 + 2 * UNIT, SIDE = (size_t)256 * 1024, WS_MS = WS_GS + 3 * SIDE * 2, WS_MIXP = WS_MS + 3 * SIDE * 2, WS_FP = WS_MIXP + 3 * SIDE * 4, WS_RS = WS_FP + 4 * SIDE * 4, WS_BAR = WS_RS + 2 * (size_t)MP * 4 + 4096 - (2 * (size_t)MP * 4) % 4096, WS_END = WS_BAR + 16384;

struct Params { const float* in[20]; float* out; unsigned char* ws; };
typedef const __attribute__((address_space(4))) Params* PP;

typedef __bf16 bf16v2 __attribute__((ext_vector_type(2)));
__device__ __forceinline__ unsigned cvt_pk_bf16(float lo, float hi) { return __builtin_bit_cast(unsigned, __builtin_convertvector((f32x2){lo, hi}, bf16v2)); }
__device__ __forceinline__ float bf_lo(unsigned w) { return __uint_as_float(w << 16); }
__device__ __forceinline__ float bf_hi(unsigned w) { return __uint_as_float(w & 0xffff0000u); }
__device__ __forceinline__ void unpack8(const u32x4 w, float (&f)[8]) {
    f[0] = bf_lo(w.x); f[1] = bf_hi(w.x); f[2] = bf_lo(w.y); f[3] = bf_hi(w.y); f[4] = bf_lo(w.z); f[5] = bf_hi(w.z); f[6] = bf_lo(w.w); f[7] = bf_hi(w.w); }
__device__ __forceinline__ u32x4 pack8(const float (&f)[8]) { u32x4 w; w.x = cvt_pk_bf16(f[0], f[1]); w.y = cvt_pk_bf16(f[2], f[3]); w.z = cvt_pk_bf16(f[4], f[5]); w.w = cvt_pk_bf16(f[6], f[7]); return w; }
__device__ __forceinline__ float wave_sum(float v) {
#pragma unroll
    for (int o = 32; o >= 1; o >>= 1) v += __shfl_xor(v, o);
    return v; }
__device__ __forceinline__ int opaque_tid() { int t = threadIdx.x; asm volatile("" : "+v"(t)); return t; }
#define OPQ_S(x) asm volatile("" : "+s"(x))
__device__ __forceinline__ float sigmoidf_(float x) { return __builtin_amdgcn_rcpf(1.0f + __expf(-x)); }

__device__ __forceinline__ void st16(void* p, u32x4 v) { *(u32x4*)p = v; }
__device__ __forceinline__ void st16(void* p, f32x4 v) { *(f32x4*)p = v; }
__device__ __forceinline__ void st8(void* p, u32x2 v) { *(u32x2*)p = v; }
__device__ __forceinline__ void st4(void* p, unsigned v) { *(unsigned*)p = v; }

constexpr int BM = 256, BK = 64, HALF = 128, HTB = HALF * BK * 2, STAGE_BYTES = 8 * HTB, NXCD = 8, WGM = 8;
__device__ __forceinline__ int lds_byte(int r, int c) { const int st = (r >> 4) * 2 + (c >> 5), rr = r & 15, cc = c & 31, ob = rr * 64 + cc * 2; return st * 1024 + (ob ^ (((ob >> 9) & 1) << 5)); }
__device__ __forceinline__ void stage_rc(int b, int& R, int& C) { const int st = b / 1024, sb = b % 1024, swz = sb ^ (((sb >> 9) & 1) << 5); R = (st >> 1) * 16 + swz / 64; C = (st & 1) * 32 + (swz % 64) / 2; }
__device__ __forceinline__ int perm32(int rho) { const int n = rho >> 4, i = rho & 15; return 8 * (i >> 2) + 4 * n + (i & 3); }

struct Unit { int pm, pn, tag; const char* a; const char* b; };

struct Extra { int n, per; const char* a0; const char* b0; size_t a_tag_bytes, b_tag_bytes, a_pn_bytes, b_pn_bytes;
    __device__ __forceinline__ bool get(int e, Unit& u) const { if (e >= n) return false; const int tag = e / per, pn = e - tag * per;
        u.pm = 128; u.pn = pn; u.tag = tag; u.a = a0 + (size_t)tag * a_tag_bytes + (size_t)pn * a_pn_bytes; u.b = b0 + (size_t)tag * b_tag_bytes + (size_t)pn * b_pn_bytes; return true; } };
struct PhaseOrder {
    const char* A; const char* Bt; size_t tstepA, tstepB, a_pn_bytes; int nN, nwg, rounds, G, c; Extra X;
    __device__ __forceinline__ void init(const void* A_, const void* Bt_, int lda, int ldb, int a_pn_cols, int nN_, bool prompt) {
        A = (const char*)A_; Bt = (const char*)Bt_; tstepA = (size_t)512 * lda; tstepB = (size_t)512 * ldb; a_pn_bytes = (size_t)a_pn_cols * 2; nN = nN_; nwg = prompt ? 128 * nN_ : 0;
        G = (int)gridDim.x; c = (int)blockIdx.x; rounds = (nwg + G - 1) / G; X = Extra{0, 1, nullptr, nullptr, 0, 0, 0, 0}; }
    __device__ __forceinline__ bool next(int i, Unit& u) const {
        if (i < rounds) { const long L = (long)i * G + c; if (L >= nwg) return false;
            int wgid = (int)L; { const int q = nwg / NXCD, r = nwg % NXCD, xcd = wgid % NXCD, off = wgid / NXCD; wgid = (xcd < r ? xcd * (q + 1) : r * (q + 1) + (xcd - r) * q) + off; }
            const int nig = WGM * nN, gid = wgid / nig, fm = gid * WGM;
            u.pm = fm + ((wgid % nig) % WGM); u.pn = (wgid % nig) / WGM; u.tag = -1; u.a = A + (size_t)u.pm * tstepA + (size_t)u.pn * a_pn_bytes; u.b = Bt + (size_t)u.pn * tstepB; return true; }
        if (i == rounds) return X.get(c, u);
        return false;
    }
};

typedef f32x4 Acc[2][2][4][2];

template <class Epi>
__device__ __forceinline__ void gemm_phase(LAS unsigned char* lds, const int K, const int lda, const int ldb, const PhaseOrder& S, const Epi& E) {
    const int tid = opaque_tid(), wid = __builtin_amdgcn_readfirstlane(tid >> 6), lane = tid & 63, wr = wid >> 2, wc = wid & 3, fr = lane & 15, fq = lane >> 4;
    const int nt = K / BK;
    unsigned voffA[2], voffB[2];
#pragma unroll
    for (int i = 0; i < 2; ++i) { int R, C; stage_rc(tid * 16 + i * 8192, R, C); const int Rb = Epi::PERM ? ((R & ~31) + perm32(R & 31)) : R;
        voffA[i] = (unsigned)(R * lda + C) * 2u; voffB[i] = (unsigned)(Rb * ldb + C) * 2u; }
    const size_t kstep = (size_t)(BK * 2);
    const size_t hstepA = (size_t)HALF * lda * 2, hstepB = (size_t)HALF * ldb * 2;
    const unsigned ldsw = (unsigned)wid * 1024u;
    const int aoff = lds_byte(wr * 64 + fr, fq * 8), boff = lds_byte(wc * 32 + fr, fq * 8);
#define PG8_SA(b, h) (((b) * 2 + (h)) * HTB)
#define PG8_SB(b, h) ((4 + (b) * 2 + (h)) * HTB)
#define PG8_STAGE(bufoff, gbase, voff) do { _Pragma("unroll") for (int _i = 0; _i < 2; ++_i) \
        __builtin_amdgcn_global_load_lds((const unsigned*)((const char*)(gbase) + (voff)[_i]), (LAS unsigned*)(lds + (bufoff) + ldsw + _i * 8192), 16, 0, 0); } while (0)
#define PG8_LDA(dst, b, h) do { _Pragma("unroll") for (int m = 0; m < 4; ++m) _Pragma("unroll") for (int k = 0; k < 2; ++k) dst[m][k] = *(const LAS bf16x8*)(lds + PG8_SA(b, h) + aoff + m * 2048 + k * 1024); } while (0)
#define PG8_LDB(dst, b, h) do { _Pragma("unroll") for (int n = 0; n < 2; ++n) _Pragma("unroll") for (int k = 0; k < 2; ++k) dst[n][k] = *(const LAS bf16x8*)(lds + PG8_SB(b, h) + boff + n * 2048 + k * 1024); } while (0)
#define PG8_MMA(ai, bj, At, Bt) do { __builtin_amdgcn_s_setprio(1); _Pragma("unroll") for (int m = 0; m < 4; ++m) _Pragma("unroll") for (int n = 0; n < 2; ++n) _Pragma("unroll") for (int k = 0; k < 2; ++k) \
        acc[ai][bj][m][n] = __builtin_amdgcn_mfma_f32_16x16x32_bf16(Bt[n][k], At[m][k], acc[ai][bj][m][n], 0, 0, 0); __builtin_amdgcn_s_setprio(0); } while (0)
#define PG8_WAIT_V(n) asm volatile("s_waitcnt vmcnt(" #n ")" ::: "memory")
#define PG8_WAIT_L(n) asm volatile("s_waitcnt lgkmcnt(" #n ")" ::: "memory")
#define PG8_BAR __builtin_amdgcn_s_barrier()
#define PG8_SCHED __builtin_amdgcn_sched_barrier(0)
    Unit cur, nxt; int ui = 0;
    if (!S.next(0, cur)) return;
    Acc acc;
#pragma unroll
    for (int a = 0; a < 2; ++a)
#pragma unroll
        for (int b = 0; b < 2; ++b)
#pragma unroll
            for (int m = 0; m < 4; ++m)
#pragma unroll
                for (int n = 0; n < 2; ++n) acc[a][b][m][n] = (f32x4){0.f, 0.f, 0.f, 0.f};
    bf16x8 At[4][2], B0[2][2], B1[2][2];
    const char* cA = cur.a; const char* cB = cur.b;
    PG8_STAGE(PG8_SB(0, 0), cB, voffB); PG8_STAGE(PG8_SA(0, 0), cA, voffA); PG8_STAGE(PG8_SB(0, 1), cB + hstepB, voffB); PG8_STAGE(PG8_SA(0, 1), cA + hstepA, voffA);
    if (wr == 1) PG8_BAR;
    PG8_WAIT_V(4); PG8_BAR;
    PG8_STAGE(PG8_SB(1, 0), cB + kstep, voffB); PG8_STAGE(PG8_SA(1, 0), cA + kstep, voffA); PG8_STAGE(PG8_SB(1, 1), cB + hstepB + kstep, voffB);
    PG8_WAIT_V(6); PG8_BAR;
    for (;;) {
        const bool has_next = S.next(ui + 1, nxt);
        const char* nA = has_next ? nxt.a : cA; const char* nB = has_next ? nxt.b : cB;
        for (int t = 0; t < nt; t += 2) {
            const bool last = (t == nt - 2);
            const char* a1 = cA + (size_t)(t + 1) * kstep;
            const char* a2 = last ? nA : cA + (size_t)(t + 2) * kstep; const char* b2 = last ? nB : cB + (size_t)(t + 2) * kstep;
            const char* a3 = a2 + kstep; const char* b3 = b2 + kstep;
            PG8_LDB(B0, 0, 0); PG8_SCHED; PG8_LDA(At, 0, 0); PG8_STAGE(PG8_SA(1, 1), a1 + hstepA, voffA);
            PG8_WAIT_L(8); PG8_BAR; PG8_WAIT_L(0); PG8_MMA(0, 0, At, B0); PG8_BAR; PG8_SCHED;
            PG8_LDB(B1, 0, 1); PG8_STAGE(PG8_SB(0, 0), b2, voffB);
            PG8_BAR; PG8_WAIT_L(0); PG8_MMA(0, 1, At, B1); PG8_BAR;
            PG8_LDA(At, 0, 1); PG8_STAGE(PG8_SA(0, 0), a2, voffA);
            PG8_BAR; PG8_WAIT_L(0); PG8_MMA(1, 0, At, B0); PG8_BAR; PG8_SCHED;
            PG8_STAGE(PG8_SB(0, 1), b2 + hstepB, voffB);
            PG8_WAIT_V(6); PG8_BAR; PG8_MMA(1, 1, At, B1); PG8_BAR;
            PG8_LDB(B0, 1, 0); PG8_SCHED; PG8_LDA(At, 1, 0); PG8_STAGE(PG8_SA(0, 1), a2 + hstepA, voffA);
            PG8_WAIT_L(8); PG8_BAR; PG8_WAIT_L(0); PG8_MMA(0, 0, At, B0); PG8_BAR; PG8_SCHED;
            PG8_LDB(B1, 1, 1); PG8_STAGE(PG8_SB(1, 0), b3, voffB);
            PG8_BAR; PG8_WAIT_L(0); PG8_MMA(0, 1, At, B1); PG8_BAR;
            PG8_LDA(At, 1, 1); PG8_STAGE(PG8_SA(1, 0), a3, voffA);
            PG8_BAR; PG8_WAIT_L(0); PG8_MMA(1, 0, At, B0); PG8_BAR; PG8_SCHED;
            PG8_STAGE(PG8_SB(1, 1), b3 + hstepB, voffB);
            PG8_WAIT_V(6); PG8_BAR; PG8_MMA(1, 1, At, B1); PG8_BAR;
        }
        E(acc, cur, wr, wc, fr, fq);
        if (!has_next) break;
#pragma unroll
        for (int a = 0; a < 2; ++a)
#pragma unroll
            for (int b = 0; b < 2; ++b)
#pragma unroll
                for (int m = 0; m < 4; ++m)
#pragma unroll
                    for (int n = 0; n < 2; ++n) acc[a][b][m][n] = (f32x4){0.f, 0.f, 0.f, 0.f};
        cur = nxt; cA = nA; cB = nB; ++ui;
    }
    PG8_WAIT_V(0);
    if (wr == 0) PG8_BAR;
    PG8_BAR;
#undef PG8_SA
#undef PG8_SB
#undef PG8_STAGE
#undef PG8_LDA
#undef PG8_LDB
#undef PG8_MMA
#undef PG8_WAIT_V
#undef PG8_WAIT_L
#undef PG8_BAR
#undef PG8_SCHED
}

__device__ __forceinline__ u32x4 pk2x4(const f32x4 v0, const f32x4 v1) { u32x4 w; w.x = cvt_pk_bf16(v0[0], v0[1]); w.y = cvt_pk_bf16(v0[2], v0[3]); w.z = cvt_pk_bf16(v1[0], v1[1]); w.w = cvt_pk_bf16(v1[2], v1[3]); return w; }

struct EpiMain {
    static constexpr bool PERM = true;
    bf16_t *Ub, *BGb, *UPb, *Qb, *Kb, *Vb; const f32x4* rope; bf16_t* GS; const float* RS;
    __device__ __forceinline__ void operator()(const Acc& acc, const Unit& u, int wr, int wc, int fr, int fq) const {
        const int row0 = u.pm * BM + wr * 64 + fr, pn = u.pn;
        float rs[2][4];
#pragma unroll
        for (int ai = 0; ai < 2; ++ai)
#pragma unroll
            for (int m = 0; m < 4; ++m) rs[ai][m] = RS[row0 + ai * HALF + m * 16];
        if (pn < 8) {
#pragma unroll
            for (int ai = 0; ai < 2; ++ai)
#pragma unroll
                for (int m = 0; m < 4; ++m) { const size_t row = row0 + ai * HALF + m * 16;
                    st16(Ub + row * 1024 + pn * 128 + wc * 32 + fq * 8, pk2x4(acc[ai][0][m][0] * acc[ai][1][m][0] * (rs[ai][m] * rs[ai][m]), acc[ai][0][m][1] * acc[ai][1][m][1] * (rs[ai][m] * rs[ai][m]))); __builtin_amdgcn_sched_barrier(0); }
        } else if (pn < 16) {
            bf16_t* base = (pn < 12 ? BGb : UPb) + (pn & 3) * 256 + wc * 32 + fq * 8;
#pragma unroll
            for (int ai = 0; ai < 2; ++ai)
#pragma unroll
                for (int m = 0; m < 4; ++m) { const size_t row = row0 + ai * HALF + m * 16;
#pragma unroll
                    for (int bj = 0; bj < 2; ++bj) st16(base + row * 1024 + bj * HALF, pk2x4(acc[ai][bj][m][0] * rs[ai][m], acc[ai][bj][m][1] * rs[ai][m])); __builtin_amdgcn_sched_barrier(0); }
        } else if (pn < 21) {
            const bool isq = pn < 20; const int ld = isq ? 1024 : 256; const float sc = isq ? 0.125f * 1.4426950408889634f : 1.0f;
            bf16_t* base = (isq ? Qb + (pn - 16) * 256 : Kb) + wc * 64 + fq * 8;
#pragma unroll
            for (int am = 0; am < 4; ++am) { const int ai = am >> 1, mh = (am & 1) * 2;
                f32x4 cs[2][4];
#pragma unroll
                for (int mm = 0; mm < 2; ++mm) { const int row = row0 + ai * HALF + (mh + mm) * 16; const int pos = row < MPR ? (row & (TSEQ - 1)) : TSEQ;
                    const f32x4* rp = rope + (size_t)pos * 16 + fq * 4;
#pragma unroll
                    for (int q = 0; q < 4; ++q) cs[mm][q] = rp[q]; }
                __builtin_amdgcn_sched_barrier(0);
#pragma unroll
                for (int mm = 0; mm < 2; ++mm) { const int m = mh + mm; const int row = row0 + ai * HALF + m * 16;
                    f32x4 o1[2], o2[2];
#pragma unroll
                    for (int n = 0; n < 2; ++n) { const f32x4 cs0 = cs[mm][2 * n], cs1 = cs[mm][2 * n + 1]; const f32x4 x1 = acc[ai][0][m][n], x2 = acc[ai][1][m][n];
                        const float scr = sc * rs[ai][m]; const f32x4 c = (f32x4){cs0[0], cs0[2], cs1[0], cs1[2]} * scr, s = (f32x4){cs0[1], cs0[3], cs1[1], cs1[3]} * scr;
                        o1[n] = x1 * c - x2 * s; o2[n] = x2 * c + x1 * s; }
                    st16(base + (size_t)row * ld, pk2x4(o1[0], o1[1])); st16(base + (size_t)row * ld + 32, pk2x4(o2[0], o2[1])); __builtin_amdgcn_sched_barrier(0); }
            }
        } else if (pn == 21) {
            bf16_t* base = Vb + wc * 32 + fq * 8;
#pragma unroll
            for (int ai = 0; ai < 2; ++ai)
#pragma unroll
                for (int m = 0; m < 4; ++m) { const size_t row = row0 + ai * HALF + m * 16;
#pragma unroll
                    for (int bj = 0; bj < 2; ++bj) st16(base + row * 256 + bj * HALF, pk2x4(acc[ai][bj][m][0] * rs[ai][m], acc[ai][bj][m][1] * rs[ai][m])); __builtin_amdgcn_sched_barrier(0); }
        } else {
            const int gi = (pn - 22) >> 2; bf16_t* base = GS + (size_t)gi * SIDE + ((pn - 22) & 3) * 256 + wc * 32 + fq * 8;
#pragma unroll
            for (int ai = 0; ai < 2; ++ai)
#pragma unroll
                for (int m = 0; m < 4; ++m) { const size_t rl = (size_t)(row0 - MPR + ai * HALF + m * 16);
#pragma unroll
                    for (int bj = 0; bj < 2; ++bj) { f32x4 v0 = acc[ai][bj][m][0], v1 = acc[ai][bj][m][1];
#pragma unroll
                        for (int j = 0; j < 4; ++j) { v0[j] = sigmoidf_(v0[j] * rs[ai][m]); v1[j] = sigmoidf_(v1[j] * rs[ai][m]); }
                        st16(base + rl * 1024 + bj * HALF, pk2x4(v0, v1)); } __builtin_amdgcn_sched_barrier(0); }
        }
    }
};
template <int ACT> struct EpiAct {
    static constexpr bool PERM = true;
    bf16_t* O; int ldc; const float* RS;
    __device__ __forceinline__ void operator()(const Acc& acc, const Unit& u, int wr, int wc, int fr, int fq) const {
        const int row0 = u.pm * BM + wr * 64 + fr; bf16_t* base = O + u.pn * BM + wc * 32 + fq * 8;
        float rsv[2][4];
#pragma unroll
        for (int ai = 0; ai < 2; ++ai)
#pragma unroll
            for (int m = 0; m < 4; ++m) rsv[ai][m] = RS[row0 + ai * HALF + m * 16];
#pragma unroll
        for (int ai = 0; ai < 2; ++ai)
#pragma unroll
            for (int m = 0; m < 4; ++m) { const size_t row = row0 + ai * HALF + m * 16; const float rs = rsv[ai][m];
#pragma unroll
                for (int bj = 0; bj < 2; ++bj) { f32x4 v0 = acc[ai][bj][m][0], v1 = acc[ai][bj][m][1];
#pragma unroll
                    for (int j = 0; j < 4; ++j) { if (ACT == 0) { v0[j] = sigmoidf_(v0[j] * rs); v1[j] = sigmoidf_(v1[j] * rs); } else { const float a = fmaxf(v0[j] * rs, 0.f), b = fmaxf(v1[j] * rs, 0.f); v0[j] = a * a; v1[j] = b * b; } }
                    st16(base + row * ldc + bj * HALF, pk2x4(v0, v1)); __builtin_amdgcn_sched_barrier(0); } }
    }
};
struct EpiGate {
    static constexpr bool PERM = true;
    bf16_t* MG; const bf16_t* SG; bool accum; const bf16_t* GS; bf16_t* MS; int g0, g1;
    __device__ __forceinline__ void operator()(const Acc& acc, const Unit& u, int wr, int wc, int fr, int fq) const {
        const bool smp = u.tag >= 0; const int gi = u.tag == 0 ? g0 : g1;
        const int row0 = (smp ? 0 : u.pm * BM) + wr * 64 + fr, col0 = u.pn * BM + wc * 32 + fq * 8;
        const bf16_t* sgb = smp ? GS + (size_t)gi * SIDE : SG; bf16_t* mgb = smp ? MS + (size_t)gi * SIDE : MG; const bool acc_on = accum && !smp;
#pragma unroll
        for (int ai = 0; ai < 2; ++ai) {
            u32x4 sgv[4][2], mgv[4][2];
#pragma unroll
            for (int m = 0; m < 4; ++m)
#pragma unroll
                for (int bj = 0; bj < 2; ++bj) { const size_t off = (size_t)(row0 + ai * HALF + m * 16) * 1024 + col0 + bj * HALF;
                    sgv[m][bj] = *(const u32x4*)(sgb + off); mgv[m][bj] = acc_on ? *(const u32x4*)(mgb + off) : (u32x4){0u, 0u, 0u, 0u}; }
            __builtin_amdgcn_sched_barrier(0);
#pragma unroll
            for (int m = 0; m < 4; ++m) {
#pragma unroll
                for (int bj = 0; bj < 2; ++bj) { const size_t off = (size_t)(row0 + ai * HALF + m * 16) * 1024 + col0 + bj * HALF;
                    float sg[8], mg[8]; unpack8(sgv[m][bj], sg); unpack8(mgv[m][bj], mg);
                    const f32x4 a0 = acc[ai][bj][m][0], a1 = acc[ai][bj][m][1];
#pragma unroll
                    for (int j = 0; j < 4; ++j) { mg[j] += sg[j] * a0[j]; mg[4 + j] += sg[4 + j] * a1[j]; }
                    st16(mgb + off, pack8(mg)); }
                __builtin_amdgcn_sched_barrier(0); }
        }
    }
};
struct EpiOut {
    static constexpr bool PERM = true;
    bf16_t* C; float* CS;
    __device__ __forceinline__ void operator()(const Acc& acc, const Unit& u, int wr, int wc, int fr, int fq) const {
        const bool smp = u.tag >= 0;
        const int row0 = (smp ? 0 : u.pm * BM) + wr * 64 + fr, col0 = u.pn * BM + wc * 32 + 8 * fq;
        if (!smp) {
#pragma unroll
            for (int ai = 0; ai < 2; ++ai)
#pragma unroll
                for (int m = 0; m < 4; ++m) { bf16_t* rowp = C + (size_t)(row0 + ai * HALF + m * 16) * 1024 + col0;
#pragma unroll
                    for (int bj = 0; bj < 2; ++bj) st16(rowp + bj * HALF, pk2x4(acc[ai][bj][m][0], acc[ai][bj][m][1])); __builtin_amdgcn_sched_barrier(0); }
        } else { float* cb = CS + (size_t)u.tag * SIDE;
#pragma unroll
            for (int ai = 0; ai < 2; ++ai)
#pragma unroll
                for (int m = 0; m < 4; ++m) { float* rowp = cb + (size_t)(row0 + ai * HALF + m * 16) * 1024 + col0;
#pragma unroll
                    for (int bj = 0; bj < 2; ++bj)
#pragma unroll
                        for (int n = 0; n < 2; ++n) st16(rowp + bj * HALF + n * 4, acc[ai][bj][m][n]); __builtin_amdgcn_sched_barrier(0); }
        }
    }
};

struct EpiF32 {
    static constexpr bool PERM = false;
    float* C; float* CS;
    __device__ __forceinline__ void operator()(const Acc& acc, const Unit& u, int wr, int wc, int fr, int fq) const {
        const bool smp = u.tag >= 0;
        const int row0 = (smp ? 0 : u.pm * BM) + wr * 64 + fr, col0 = u.pn * BM + wc * 32 + 4 * fq;
        float* cb = smp ? CS + (size_t)u.tag * SIDE : C;
#pragma unroll
        for (int ai = 0; ai < 2; ++ai)
#pragma unroll
            for (int m = 0; m < 4; ++m) { float* rowp = cb + (size_t)(row0 + ai * HALF + m * 16) * 1024 + col0;
#pragma unroll
                for (int bj = 0; bj < 2; ++bj)
#pragma unroll
                    for (int n = 0; n < 2; ++n) st16(rowp + bj * HALF + n * 16, acc[ai][bj][m][n]); __builtin_amdgcn_sched_barrier(0); }
    }
};

__device__ __forceinline__ int win_src_col(int n) {
    const int pn = n >> 8, w = n & 255;
    if (pn < 8) return ((w >> 7) ? 2048 : 0) + pn * 128 + (w & 127);
    if (pn < 12) return 1024 + (pn - 8) * 256 + w;
    if (pn < 16) return n;
    if (pn < 21) { const int base = pn < 20 ? 4096 + (pn - 16) * 256 : 5120; return base + ((w & 127) >> 5) * 64 + (w >> 7) * 32 + (w & 31); }
    return n;
}
__device__ __forceinline__ void convert_job(LAS unsigned char* lds, const float* src, int ld, int K, int N, bf16_t* dst, bool mapped, int& cum, const float* cscale = nullptr, int wg_first = 0, const float* kscale = nullptr) {
    const int tid = opaque_tid(), G = (int)gridDim.x - wg_first, c = (int)blockIdx.x - wg_first;
    const int nkb = K / 128, ntiles = (N / 32) * nkb;
    const int first = (c + G - (cum % G)) % G; cum += ntiles;
    LAS bf16_t* tile = (LAS bf16_t*)lds;
    const int c4 = tid & 7, kr = tid >> 3;
    f32x4 v[2]; f32x4 cs = (f32x4){1.f, 1.f, 1.f, 1.f};
    if (first < ntiles) { const int nb = first / nkb, kb = first % nkb, n0 = nb * 32, k0 = kb * 128; const int sc0 = mapped ? win_src_col(n0) : n0;
#pragma unroll
        for (int i = 0; i < 2; ++i) v[i] = *(const f32x4*)(src + (size_t)(k0 + kr + 64 * i) * ld + sc0 + 4 * c4);
        if (cscale) cs = *(const f32x4*)(cscale + sc0 + 4 * c4); }
    for (int ti = first; ti < ntiles; ti += G) {
        const int nb = ti / nkb, kb = ti % nkb, n0 = nb * 32, k0 = kb * 128;
        __syncthreads();
#pragma unroll
        for (int i = 0; i < 2; ++i) { const int kk = kr + 64 * i; const f32x4 w = v[i] * cs * (kscale ? kscale[k0 + kk] : 1.0f); const unsigned p0 = cvt_pk_bf16(w[0], w[1]), p1 = cvt_pk_bf16(w[2], w[3]);
            tile[(4 * c4 + 0) * 136 + kk] = (bf16_t)(p0 & 0xffff); tile[(4 * c4 + 1) * 136 + kk] = (bf16_t)(p0 >> 16);
            tile[(4 * c4 + 2) * 136 + kk] = (bf16_t)(p1 & 0xffff); tile[(4 * c4 + 3) * 136 + kk] = (bf16_t)(p1 >> 16); }
        __syncthreads();
        const int tn = ti + G;
        if (tn < ntiles) { const int nb2 = tn / nkb, kb2 = tn % nkb, n02 = nb2 * 32, k02 = kb2 * 128; const int sc2 = mapped ? win_src_col(n02) : n02;
#pragma unroll
            for (int i = 0; i < 2; ++i) v[i] = *(const f32x4*)(src + (size_t)(k02 + kr + 64 * i) * ld + sc2 + 4 * c4);
            if (cscale) cs = *(const f32x4*)(cscale + sc2 + 4 * c4); }
        const int n = tid >> 4, kk = (tid & 15) * 8;
        *(u32x4*)(dst + (size_t)(n0 + n) * K + k0 + kk) = *(const LAS u32x4*)(tile + n * 136 + kk);
    }
}
__device__ __forceinline__ void convert_layer(LAS unsigned char* lds, PP p, int l, int parts = 7, int wg_first = 0) {
    if ((int)blockIdx.x < wg_first) return;
    unsigned char* ws = p->ws; OPQ_S(ws); bf16_t* W = (bf16_t*)(ws + WS_W); int cum = 0;
    if (parts & 1) convert_job(lds, p->in[6] + (size_t)l * 1024 * NPROJ, NPROJ, 1024, NPROJ, W + WO_IN, true, cum, nullptr, wg_first, p->in[14] + l * 1024);
    if (parts & 4) {
        convert_job(lds, p->in[8] + (size_t)l * 1024 * 1024, 1024, 1024, 1024, W + WO_CO, false, cum, nullptr, wg_first);
        for (int g = 0; g < 4; ++g) convert_job(lds, p->in[9] + (size_t)l * 262144 + g * 65536, 256, 256, 256, W + WO_POOL + g * 65536, false, cum, p->in[10] + l * 1024 + g * 256, wg_first);
        convert_job(lds, p->in[12] + (size_t)l * 1024 * 1024, 1024, 1024, 1024, W + WO_AO, false, cum, nullptr, wg_first);
        convert_job(lds, p->in[13] + (size_t)l * 1024 * 1024, 1024, 1024, 1024, W + WO_MIX, false, cum, nullptr, wg_first);
    }
    if (parts & 2) {
        convert_job(lds, p->in[18] + (size_t)l * 1024 * DFF, DFF, 1024, DFF, W + WO_UP, false, cum, nullptr, wg_first, p->in[16] + l * 1024);
        convert_job(lds, p->in[19] + (size_t)l * DFF * 1024, 1024, DFF, 1024, W + WO_DN, false, cum, nullptr, wg_first);
    }
}

__device__ __forceinline__ void row_phase(const float* xin_p, const float* xin_s, const bf16_t* xin_b, float* xout_p, float* xout_s, bf16_t* xout_b, const bf16_t* Y, const float* g_post,
                                          float* RSout, const float* Ypart, int nparts, int r_lo, int r_hi, int wg_first) {
    const int tid_ = opaque_tid(); const int lane = tid_ & 63, wid = tid_ >> 6;
    constexpr int RPW = 4;
    if ((int)blockIdx.x < wg_first) return;
    for (int row0 = r_lo + (((int)blockIdx.x - wg_first) * 8 + wid) * RPW; row0 < r_hi; row0 += ((int)gridDim.x - wg_first) * 8 * RPW) {
        f32x4 x[RPW][4], y[RPW][4];
#pragma unroll
        for (int j = 0; j < RPW; ++j) { const int row = row0 + j;
            if (xin_b) {
#pragma unroll
                for (int i = 0; i < 4; ++i) { const u32x2 w = *(const u32x2*)(xin_b + (size_t)row * 1024 + i * 256 + lane * 4); x[j][i] = (f32x4){bf_lo(w.x), bf_hi(w.x), bf_lo(w.y), bf_hi(w.y)}; }
            } else { const float* xi = row < MPR ? xin_p + (size_t)row * 1024 : xin_s + (size_t)(row - MPR) * 1024;
#pragma unroll
                for (int i = 0; i < 4; ++i) x[j][i] = *(const f32x4*)(xi + i * 256 + lane * 4); } }
        if (Y) {
#pragma unroll
            for (int j = 0; j < RPW; ++j)
#pragma unroll
                for (int i = 0; i < 4; ++i) { const u32x2 w = *(const u32x2*)(Y + (size_t)(row0 + j) * 1024 + i * 256 + lane * 4); y[j][i] = (f32x4){bf_lo(w.x), bf_hi(w.x), bf_lo(w.y), bf_hi(w.y)}; }
            if (row0 >= MPR && Ypart) {
#pragma unroll
                for (int j = 0; j < RPW; ++j)
#pragma unroll
                    for (int i = 0; i < 4; ++i) y[j][i] = *(const f32x4*)(Ypart + (size_t)(row0 - MPR + j) * 1024 + i * 256 + lane * 4);
                for (int k = 1; k < nparts; ++k)
#pragma unroll
                    for (int j = 0; j < RPW; ++j)
#pragma unroll
                        for (int i = 0; i < 4; ++i) y[j][i] += *(const f32x4*)(Ypart + (size_t)k * SIDE + (size_t)(row0 - MPR + j) * 1024 + i * 256 + lane * 4);
            }
            f32x4 g[4];
#pragma unroll
            for (int i = 0; i < 4; ++i) g[i] = *(const f32x4*)(g_post + i * 256 + lane * 4);
#pragma unroll
            for (int j = 0; j < RPW; ++j) { float ss = 0.f;
#pragma unroll
                for (int i = 0; i < 4; ++i) ss += y[j][i][0] * y[j][i][0] + y[j][i][1] * y[j][i][1] + y[j][i][2] * y[j][i][2] + y[j][i][3] * y[j][i][3];
                ss = wave_sum(ss); const float rstd = rsqrtf(ss * (1.0f / 1024.0f) + RMS_EPS);
#pragma unroll
                for (int i = 0; i < 4; ++i) x[j][i] += y[j][i] * rstd * g[i]; }
        }
#pragma unroll
        for (int j = 0; j < RPW; ++j) { const int row = row0 + j;
            if (xout_b) {
#pragma unroll
                for (int i = 0; i < 4; ++i) { u32x2 w; w.x = cvt_pk_bf16(x[j][i][0], x[j][i][1]); w.y = cvt_pk_bf16(x[j][i][2], x[j][i][3]);
                    st8(xout_b + (size_t)row * 1024 + i * 256 + lane * 4, w);
                    x[j][i] = (f32x4){bf_lo(w.x), bf_hi(w.x), bf_lo(w.y), bf_hi(w.y)}; }
            } else if (xout_p) { float* xo = row < MPR ? xout_p + (size_t)row * 1024 : xout_s + (size_t)(row - MPR) * 1024;
#pragma unroll
                for (int i = 0; i < 4; ++i) *(f32x4*)(xo + i * 256 + lane * 4) = x[j][i]; }
            if (RSout) { float ss = 0.f;
#pragma unroll
                for (int i = 0; i < 4; ++i) ss += x[j][i][0] * x[j][i][0] + x[j][i][1] * x[j][i][1] + x[j][i][2] * x[j][i][2] + x[j][i][3] * x[j][i][3];
                ss = wave_sum(ss); if (lane == 0) RSout[row] = rsqrtf(ss * (1.0f / 1024.0f) + RMS_EPS); }
        }
    }
}

__device__ __forceinline__ void rope_table(f32x2* tab) {
    for (int i = blockIdx.x * 512 + opaque_tid(); i < 8193 * 32; i += gridDim.x * 512) {
        const int pos = i >> 5, d = i & 31; const float fpos = pos == 8192 ? 16384.0f : (float)pos;
        const float inv = powf(10000.0f, -(float)d / 32.0f); const float ang = fpos * inv;
        float s, c; sincosf(ang, &s, &c); tab[i] = (f32x2){c, s};
    }
}

struct AttnKV { u32x4 k[4]; u32x4 va[2], vb[2]; bf16x8 q[2][2]; };
__device__ __forceinline__ void attn_load_kv(int tid, int item, const bf16_t* Kb, const bf16_t* Vb, const bf16_t* Qb, AttnKV& r) {
    const int kvh = item & 3, qb = (item >> 2) & 63, b = item >> 8; const int rb = b * TSEQ + qb * 128;
    { const int wid = tid >> 6, lane = tid & 63, fr = lane & 15, fq = lane >> 4, hl = wid >> 1, half = wid & 1, head = kvh * 4 + hl;
#pragma unroll
      for (int qt = 0; qt < 2; ++qt) { const bf16_t* qrow = Qb + (size_t)(rb + half * 64 + qt * 16 + fr) * 1024 + head * 64 + fq * 8; r.q[qt][0] = *(const bf16x8*)qrow; r.q[qt][1] = *(const bf16x8*)(qrow + 32); } }
#pragma unroll
    for (int i = 0; i < 4; ++i) { const int id = tid + 512 * i, j = id >> 3, c8 = id & 7; const long tok = (long)rb - 128 + j;
        r.k[i] = (qb > 0 || j >= 128) ? *(const u32x4*)(Kb + tok * 256 + kvh * 64 + c8 * 8) : (u32x4){0u, 0u, 0u, 0u}; }
#pragma unroll
    for (int i = 0; i < 2; ++i) { const int id = tid + 512 * i, jp = id >> 3, c8 = id & 7; const long tok = (long)rb - 128 + 2 * jp;
        if (qb > 0 || jp >= 64) { r.va[i] = *(const u32x4*)(Vb + tok * 256 + kvh * 64 + c8 * 8); r.vb[i] = *(const u32x4*)(Vb + (tok + 1) * 256 + kvh * 64 + c8 * 8); }
        else { r.va[i] = (u32x4){0u, 0u, 0u, 0u}; r.vb[i] = (u32x4){0u, 0u, 0u, 0u}; } }
}
__device__ __forceinline__ void attn_store_kv(LAS unsigned char* lds, int tid, const AttnKV& r) {
    LAS bf16_t* Ks = (LAS bf16_t*)lds;
    LAS bf16_t* Vt = (LAS bf16_t*)(lds + 36864);
#pragma unroll
    for (int i = 0; i < 4; ++i) { const int id = tid + 512 * i, j = id >> 3, c8 = id & 7; *(LAS u32x4*)(Ks + j * 72 + c8 * 8) = r.k[i]; }
#pragma unroll
    for (int i = 0; i < 2; ++i) { const int id = tid + 512 * i, jp = id >> 3, c8 = id & 7; LAS unsigned* vp = (LAS unsigned*)(Vt + (c8 * 8) * 264 + 2 * jp);
        const u32x4 a = r.va[i], bq = r.vb[i];
        vp[0 * 132] = (a.x & 0xffffu) | (bq.x << 16); vp[1 * 132] = (a.x >> 16) | (bq.x & 0xffff0000u);
        vp[2 * 132] = (a.y & 0xffffu) | (bq.y << 16); vp[3 * 132] = (a.y >> 16) | (bq.y & 0xffff0000u);
        vp[4 * 132] = (a.z & 0xffffu) | (bq.z << 16); vp[5 * 132] = (a.z >> 16) | (bq.z & 0xffff0000u);
        vp[6 * 132] = (a.w & 0xffffu) | (bq.w << 16); vp[7 * 132] = (a.w >> 16) | (bq.w & 0xffff0000u); }
}
__device__ __forceinline__ void attn_prompt_compute(LAS unsigned char* lds, int item, bf16_t* Qb, const bf16x8 (&q01)[2][2], const float* sinks, bf16_t* Ob) {
    const int tid = opaque_tid(), wid = tid >> 6, lane = tid & 63, fr = lane & 15, fq = lane >> 4;
    const int kvh = item & 3, qb = (item >> 2) & 63, b = item >> 8;
    const int rb = b * TSEQ + qb * 128;
    LAS bf16_t* Ks = (LAS bf16_t*)lds;
    LAS bf16_t* Vt = (LAS bf16_t*)(lds + 36864);
    const int hl = wid >> 1, half = wid & 1, head = kvh * 4 + hl;
    const float sink = sinks[head] * 1.4426950408889634f;
    bf16x8 qf[4][2];
    qf[0][0] = q01[0][0]; qf[0][1] = q01[0][1]; qf[1][0] = q01[1][0]; qf[1][1] = q01[1][1];
#pragma unroll
    for (int qt = 2; qt < 4; ++qt) { const bf16_t* qrow = Qb + (size_t)(rb + half * 64 + qt * 16 + fr) * 1024 + head * 64 + fq * 8; qf[qt][0] = *(const bf16x8*)qrow; qf[qt][1] = *(const bf16x8*)(qrow + 32); }
#pragma unroll
    for (int qp = 0; qp < 2; ++qp) {
        const int i0p = half * 64 + qp * 32;
        const int js = min(i0p, 96);
        f32x4 S[2][10];
        __builtin_amdgcn_s_setprio(1);
#pragma unroll
        for (int kt = 0; kt < 10; ++kt) {
            const LAS bf16_t* kp = Ks + (js + kt * 16 + fr) * 72 + fq * 8;
            const bf16x8 k0 = *(const LAS bf16x8*)kp, k1 = *(const LAS bf16x8*)(kp + 32);
#pragma unroll
            for (int u = 0; u < 2; ++u) { f32x4 sv = (f32x4){0.f, 0.f, 0.f, 0.f};
                sv = __builtin_amdgcn_mfma_f32_16x16x32_bf16(k0, qf[2 * qp + u][0], sv, 0, 0, 0);
                sv = __builtin_amdgcn_mfma_f32_16x16x32_bf16(k1, qf[2 * qp + u][1], sv, 0, 0, 0);
                S[u][kt] = sv; }
        }
        __builtin_amdgcn_s_setprio(0);
        float mx[2], rden[2];
#pragma unroll
        for (int u = 0; u < 2; ++u) { const int i0 = i0p + 16 * u, iq = i0 + fr; float m = -1e30f;
#pragma unroll
            for (int kt = 0; kt < 10; ++kt) { const int jb = js + kt * 16;
                const bool interior = (jb >= i0 + 16) && (jb <= i0 + 113) && (qb > 0 || jb >= 128);
                if (interior) {
#pragma unroll
                    for (int r = 0; r < 4; ++r) m = fmaxf(m, S[u][kt][r]);
                } else {
#pragma unroll
                    for (int r = 0; r < 4; ++r) { const int j = jb + fq * 4 + r; const int dlt = j - iq;
                        const bool ok = (dlt >= 1) && (dlt <= 128) && (qb > 0 || j >= 128);
                        const float v = ok ? S[u][kt][r] : -1e30f; S[u][kt][r] = v; m = fmaxf(m, v); } } }
            mx[u] = m; }
#pragma unroll
        for (int u = 0; u < 2; ++u) { float m = mx[u]; m = fmaxf(m, __shfl_xor(m, 16)); m = fmaxf(m, __shfl_xor(m, 32)); mx[u] = fmaxf(m, sink); }
#pragma unroll
        for (int u = 0; u < 2; ++u) { float sum = 0.f;
#pragma unroll
            for (int kt = 0; kt < 10; ++kt)
#pragma unroll
                for (int r = 0; r < 4; ++r) { const float e = __builtin_amdgcn_exp2f(S[u][kt][r] - mx[u]); S[u][kt][r] = e; sum += e; }
            rden[u] = sum; }
#pragma unroll
        for (int u = 0; u < 2; ++u) { float sum = rden[u]; sum += __shfl_xor(sum, 16); sum += __shfl_xor(sum, 32); rden[u] = 1.0f / (sum + __builtin_amdgcn_exp2f(sink - mx[u])); }
        f32x4 O[2][4];
#pragma unroll
        for (int u = 0; u < 2; ++u)
#pragma unroll
            for (int dt = 0; dt < 4; ++dt) O[u][dt] = (f32x4){0.f, 0.f, 0.f, 0.f};
        __builtin_amdgcn_s_setprio(1);
#pragma unroll
        for (int kp = 0; kp < 5; ++kp) {
            bf16x8 pf[2];
#pragma unroll
            for (int u = 0; u < 2; ++u) { u32x4 pw; pw.x = cvt_pk_bf16(S[u][2 * kp][0], S[u][2 * kp][1]); pw.y = cvt_pk_bf16(S[u][2 * kp][2], S[u][2 * kp][3]);
                pw.z = cvt_pk_bf16(S[u][2 * kp + 1][0], S[u][2 * kp + 1][1]); pw.w = cvt_pk_bf16(S[u][2 * kp + 1][2], S[u][2 * kp + 1][3]); pf[u] = __builtin_bit_cast(bf16x8, pw); }
            const int jb0 = js + 32 * kp;
#pragma unroll
            for (int dt = 0; dt < 4; ++dt) {
                const LAS bf16_t* vp = Vt + (dt * 16 + fr) * 264 + jb0 + 4 * fq;
                const u32x2 v0 = *(const LAS u32x2*)vp, v1 = *(const LAS u32x2*)(vp + 16);
                const bf16x8 vf = __builtin_bit_cast(bf16x8, (u32x4){v0.x, v0.y, v1.x, v1.y});
#pragma unroll
                for (int u = 0; u < 2; ++u) O[u][dt] = __builtin_amdgcn_mfma_f32_16x16x32_bf16(pf[u], vf, O[u][dt], 0, 0, 0);
            }
        }
        __builtin_amdgcn_s_setprio(0);
        LAS bf16_t* Os = (LAS bf16_t*)(lds + 70656 + wid * 2304);
#pragma unroll
        for (int u = 0; u < 2; ++u) { const int i0 = i0p + 16 * u;
            float rd[4];
#pragma unroll
            for (int r = 0; r < 4; ++r) rd[r] = __shfl(rden[u], 4 * fq + r);
#pragma unroll
            for (int dt = 0; dt < 4; ++dt)
#pragma unroll
                for (int r = 0; r < 4; ++r) Os[(4 * fq + r) * 72 + dt * 16 + fr] = (bf16_t)(cvt_pk_bf16(O[u][dt][r] * rd[r], 0.f) & 0xffff);
            { const int orow = lane >> 2, seg = lane & 3; const LAS bf16_t* op = Os + orow * 72 + seg * 16;
              const u32x4 w0 = *(const LAS u32x4*)op, w1 = *(const LAS u32x4*)(op + 8);
              bf16_t* gp = Ob + (size_t)(rb + i0 + orow) * 1024 + head * 64 + seg * 16; st16(gp, w0); st16(gp + 8, w1); }
        }
    }
}

__device__ __forceinline__ int attn_item_of(int j) {
    if (gridDim.x != 256) return j;
    const int b = j >> 8, c = j & 255, xcd = c & 7, idx = c >> 3;
    return (b << 8) | ((xcd * 8 + (idx >> 2)) << 2) | (idx & 3);
}
__device__ __forceinline__ void attn_prompt_all(LAS unsigned char* lds, bf16_t* Qb, const bf16_t* Kb, const bf16_t* Vb, const float* sinks, bf16_t* Ob) {
    const int tid = opaque_tid();
    int it = blockIdx.x; AttnKV r;
    if (it < 1024) attn_load_kv(tid, attn_item_of(it), Kb, Vb, Qb, r);
    while (it < 1024) {
        __syncthreads();
        attn_store_kv(lds, tid, r);
        bf16x8 q01[2][2];
        q01[0][0] = r.q[0][0]; q01[0][1] = r.q[0][1]; q01[1][0] = r.q[1][0]; q01[1][1] = r.q[1][1];
        __syncthreads();
        const int nit = it + (int)gridDim.x;
        if (nit < 1024) attn_load_kv(tid, attn_item_of(nit), Kb, Vb, Qb, r);
        attn_prompt_compute(lds, attn_item_of(it), Qb, q01, sinks, Ob);
        it = nit;
    }
}

__device__ __forceinline__ void attn_sample_item(LAS unsigned char* lds, int item, const bf16_t* Qb, const bf16_t* Kb, const bf16_t* Vb, const float* ck, const float* cv, const float* sinks, bf16_t* Ob) {
    const int tid = opaque_tid(), lane = tid & 63, wid = tid >> 6;
    const int b = item >> 1, hh = item & 1;
    LAS float* qs = (LAS float*)lds;
    LAS float* sc = (LAS float*)(lds + 4096);
    const size_t row = (size_t)MPR + b;
    __syncthreads();
    if (tid < 256) { const unsigned w = *(const unsigned*)(Qb + row * 1024 + hh * 512 + tid * 2); qs[tid * 2] = bf_lo(w); qs[tid * 2 + 1] = bf_hi(w); }
    __syncthreads();
    { const int hl = tid >> 6, cb = tid & 63, h = hh * 8 + hl, kvh = h >> 2;
#pragma unroll
      for (int i = 0; i < 2; ++i) { const int c = cb + 64 * i; float acc = 0.f;
          if (c < 127) { const float* kp = ck + ((size_t)b * 128 + c + 1) * 256 + kvh * 64;
#pragma unroll
              for (int d = 0; d < 64; d += 4) { const f32x4 kv = *(const f32x4*)(kp + d); acc += kv[0] * qs[hl * 64 + d] + kv[1] * qs[hl * 64 + d + 1] + kv[2] * qs[hl * 64 + d + 2] + kv[3] * qs[hl * 64 + d + 3]; }
          } else { const bf16_t* kp = Kb + row * 256 + kvh * 64;
#pragma unroll
              for (int d = 0; d < 64; d += 2) { const unsigned w = *(const unsigned*)(kp + d); acc += bf_lo(w) * qs[hl * 64 + d] + bf_hi(w) * qs[hl * 64 + d + 1]; } }
          sc[hl * 128 + c] = acc; } }
    __syncthreads();
    { const int hl = wid, h = hh * 8 + hl; const float sink = sinks[h] * 1.4426950408889634f;
        const float s0 = sc[hl * 128 + lane], s1 = sc[hl * 128 + lane + 64];
        float mx = fmaxf(s0, s1);
#pragma unroll
        for (int o = 32; o >= 1; o >>= 1) mx = fmaxf(mx, __shfl_xor(mx, o));
        mx = fmaxf(mx, sink);
        const float e0 = __builtin_amdgcn_exp2f(s0 - mx), e1 = __builtin_amdgcn_exp2f(s1 - mx); const float sum = wave_sum(e0 + e1);
        const float rden = 1.0f / (sum + __builtin_amdgcn_exp2f(sink - mx));
        sc[hl * 128 + lane] = e0 * rden; sc[hl * 128 + lane + 64] = e1 * rden; }
    __syncthreads();
    { const int hl = tid >> 6, d = tid & 63, h = hh * 8 + hl, kvh = h >> 2; float o0 = 0.f;
      const float* vp = cv + ((size_t)b * 128 + 1) * 256 + kvh * 64 + d;
      for (int c0 = 0; c0 < 120; c0 += 8) { float v[8];
#pragma unroll
          for (int k = 0; k < 8; ++k) v[k] = vp[(size_t)(c0 + k) * 256];
#pragma unroll
          for (int k = 0; k < 8; ++k) o0 += sc[hl * 128 + c0 + k] * v[k]; }
      { float v[7];
#pragma unroll
          for (int k = 0; k < 7; ++k) v[k] = vp[(size_t)(120 + k) * 256];
#pragma unroll
          for (int k = 0; k < 7; ++k) o0 += sc[hl * 128 + 120 + k] * v[k]; }
      { const unsigned w = *(const unsigned*)(Vb + row * 256 + kvh * 64 + (d & ~1)); o0 += sc[hl * 128 + 127] * ((d & 1) ? bf_hi(w) : bf_lo(w)); }
      const float o1 = __shfl_xor(o0, 1);
      if (!(d & 1)) st4(Ob + row * 1024 + h * 64 + d, cvt_pk_bf16(o0, o1)); }
}

__device__ __forceinline__ void cache_shift_copy(const float* __restrict__ src, float* __restrict__ dst, int wg_first, int b_lo = 0, int b_hi = 128) {
    if ((int)blockIdx.x < wg_first) return;
    const int nthr = ((int)gridDim.x - wg_first) * 512, t0 = ((int)blockIdx.x - wg_first) * 512 + opaque_tid();
    constexpr int PER_B = 127 * 64;
    for (int i = b_lo * PER_B + t0; i < b_hi * PER_B; i += 4 * nthr) {
        f32x4 v[4];
#pragma unroll
        for (int k = 0; k < 4; ++k) { const int ii = i + k * nthr; if (ii < b_hi * PER_B) { const int b = ii / PER_B, r = ii - b * PER_B; v[k] = __builtin_nontemporal_load((const f32x4*)(src + ((size_t)b * 128 + 1) * 256 + (size_t)r * 4)); } }
#pragma unroll
        for (int k = 0; k < 4; ++k) { const int ii = i + k * nthr; if (ii < b_hi * PER_B) { const int b = ii / PER_B, r = ii - b * PER_B; __builtin_nontemporal_store(v[k], (f32x4*)(dst + (size_t)b * 128 * 256 + (size_t)r * 4)); } }
    }
}

__device__ __forceinline__ void store8f(float* o, const float (&f)[8]) { *(f32x4*)o = (f32x4){f[0], f[1], f[2], f[3]}; *(f32x4*)(o + 4) = (f32x4){f[4], f[5], f[6], f[7]}; }
__device__ __forceinline__ void load8f(const float* s, float (&f)[8]) { const f32x4 a = *(const f32x4*)s, b = *(const f32x4*)(s + 4); f[0] = a[0]; f[1] = a[1]; f[2] = a[2]; f[3] = a[3]; f[4] = b[0]; f[5] = b[1]; f[6] = b[2]; f[7] = b[3]; }

__device__ __forceinline__ void mix_elementwise(PP p, int l, const bf16_t* __restrict__ Ub, const bf16_t* BGb, const bf16_t* __restrict__ UPb, bf16_t* __restrict__ PLb, bf16_t* BGo) {
    const size_t gtid = (size_t)blockIdx.x * 512 + opaque_tid(), gstride = (size_t)gridDim.x * 512;
    const float* convw = p->in[7] + (size_t)l * 3 * 1024;
    const float* stc = p->in[2] + (size_t)l * 128 * 2 * 1024; const float* stp = p->in[3] + (size_t)l * 128 * 15 * 1024;
    const size_t gtid_x = (gridDim.x == 256) ? (size_t)(((blockIdx.x & 7u) * 32u + (blockIdx.x >> 3)) * 512u) + (gtid & 511) : gtid;
    for (size_t wi = gtid_x; wi < (size_t)(MPR / 32) * 128; wi += gstride) {
        const int c8 = (int)(wi & 127) * 8, run = (int)(wi >> 7); const int row0 = run * 32, t0 = row0 & (TSEQ - 1);
        const int g = c8 >> 8, win = 2 << g;
        float w0[8], w1[8], w2[8], u0[8], u1[8], s[8];
        load8f(convw + c8, w0); load8f(convw + 1024 + c8, w1); load8f(convw + 2048 + c8, w2);
        const size_t off0 = (size_t)row0 * 1024 + c8;
#pragma unroll
        for (int e = 0; e < 8; ++e) { u0[e] = 0.f; u1[e] = 0.f; s[e] = 0.f; }
        if (t0 > 0) {
            unpack8(*(const u32x4*)(Ub + off0 - 2048), u0); unpack8(*(const u32x4*)(Ub + off0 - 1024), u1);
            for (int k = 1; k <= win; ++k) { float v[8]; unpack8(*(const u32x4*)(UPb + off0 - (size_t)k * 1024), v);
#pragma unroll
                for (int e = 0; e < 8; ++e) s[e] += v[e]; }
        }
        u32x4 nu = *(const u32x4*)(Ub + off0), nb = *(const u32x4*)(BGb + off0), np = *(const u32x4*)(UPb + off0);
        u32x4 no = (t0 >= win) ? *(const u32x4*)(UPb + off0 - (size_t)win * 1024) : (u32x4){0u, 0u, 0u, 0u};
#pragma unroll 2
        for (int j = 0; j < 32; ++j) {
            const size_t off = off0 + (size_t)j * 1024; const int t = t0 + j;
            float u2[8], bg[8], up[8], o[8], old[8];
            unpack8(nu, u2); unpack8(nb, bg); unpack8(np, up); unpack8(no, old);
            if (j < 31) {
                nu = *(const u32x4*)(Ub + off + 1024); nb = *(const u32x4*)(BGb + off + 1024); np = *(const u32x4*)(UPb + off + 1024);
                no = (t + 1 >= win) ? *(const u32x4*)(UPb + off + 1024 - (size_t)win * 1024) : (u32x4){0u, 0u, 0u, 0u}; }
            const float rcnt = 1.0f / (float)min(win, t + 1);
#pragma unroll
            for (int e = 0; e < 8; ++e) { s[e] += up[e] - old[e]; o[e] = bg[e] * (w0[e] * u0[e] + w1[e] * u1[e] + w2[e] * u2[e]); u0[e] = u1[e]; u1[e] = u2[e]; }
            st16(BGo + off, pack8(o));
#pragma unroll
            for (int e = 0; e < 8; ++e) o[e] = s[e] * rcnt - up[e];
            st16(PLb + off, pack8(o));
        }
    }
    for (size_t i = gtid; i < (size_t)NS * 128; i += gstride) {
        const int b = (int)(i >> 7), c8 = (int)(i & 127) * 8; const size_t off = ((size_t)MPR + b) * 1024 + c8;
        float w0[8], w1[8], w2[8], u0[8], u1[8], u2[8], bg[8], up[8], s[8], o[8];
        load8f(convw + c8, w0); load8f(convw + 1024 + c8, w1); load8f(convw + 2048 + c8, w2);
        unpack8(*(const u32x4*)(Ub + off), u2); unpack8(*(const u32x4*)(BGb + off), bg); unpack8(*(const u32x4*)(UPb + off), up);
        const int g = c8 >> 8, win = 2 << g;
#pragma unroll
        for (int e = 0; e < 8; ++e) s[e] = up[e];
        load8f(stc + (size_t)(b * 2 + 0) * 1024 + c8, u0); load8f(stc + (size_t)(b * 2 + 1) * 1024 + c8, u1);
        for (int k = 1; k < win; ++k) { float v[8]; load8f(stp + (size_t)(b * 15 + 15 - k) * 1024 + c8, v);
#pragma unroll
            for (int e = 0; e < 8; ++e) s[e] += v[e]; }
        const float rcnt = 1.0f / (float)win;
#pragma unroll
        for (int e = 0; e < 8; ++e) o[e] = bg[e] * (w0[e] * u0[e] + w1[e] * u1[e] + w2[e] * u2[e]);
        st16(BGo + off, pack8(o));
#pragma unroll
        for (int e = 0; e < 8; ++e) o[e] = s[e] * rcnt - up[e];
        st16(PLb + off, pack8(o));
    }
}
__device__ __forceinline__ void state_outputs(PP p, int l, const bf16_t* Ub, const bf16_t* UPb, const bf16_t* Kb, const bf16_t* Vb) {
    const size_t gtid = (size_t)blockIdx.x * 512 + opaque_tid(), gstride = (size_t)gridDim.x * 512;
    const float* stc = p->in[2] + (size_t)l * 128 * 2 * 1024; const float* stp = p->in[3] + (size_t)l * 128 * 15 * 1024;
    float* out = p->out; float f[8];
    for (size_t i = gtid; i < 4 * 2 * 128; i += gstride) { const int b = (int)(i >> 8), r = (int)(i >> 7) & 1, c8 = (int)(i & 127) * 8;
        unpack8(*(const u32x4*)(Ub + ((size_t)b * TSEQ + TSEQ - 2 + r) * 1024 + c8), f); store8f(out + O_PC + (size_t)l * 8192 + (b * 2 + r) * 1024 + c8, f); }
    for (size_t i = gtid; i < 4 * 15 * 128; i += gstride) { const int b = (int)(i / 1920), r = (int)(i >> 7) % 15, c8 = (int)(i & 127) * 8;
        unpack8(*(const u32x4*)(UPb + ((size_t)b * TSEQ + TSEQ - 15 + r) * 1024 + c8), f); store8f(out + O_PP + (size_t)l * 61440 + (b * 15 + r) * 1024 + c8, f); }
    for (size_t i = gtid; i < 4 * 128 * 32; i += gstride) { const int b = (int)(i >> 12), sidx = (int)(i >> 5) & 127, c8 = (int)(i & 31) * 8; const size_t so = ((size_t)b * TSEQ + TSEQ - 128 + sidx) * 256 + c8, oo = (size_t)l * 131072 + (b * 128 + sidx) * 256 + c8;
        unpack8(*(const u32x4*)(Kb + so), f); store8f(out + O_PK + oo, f); unpack8(*(const u32x4*)(Vb + so), f); store8f(out + O_PV + oo, f); }
    for (size_t i = gtid; i < 128 * 2 * 128; i += gstride) { const int b = (int)(i >> 8), r = (int)(i >> 7) & 1, c8 = (int)(i & 127) * 8;
        if (r == 0) load8f(stc + (size_t)(b * 2 + 1) * 1024 + c8, f); else unpack8(*(const u32x4*)(Ub + ((size_t)MPR + b) * 1024 + c8), f);
        store8f(out + O_SC + (size_t)l * 262144 + (b * 2 + r) * 1024 + c8, f); }
    for (size_t i = gtid; i < 128 * 15 * 128; i += gstride) { const int b = (int)(i / 1920), r = (int)(i >> 7) % 15, c8 = (int)(i & 127) * 8;
        if (r < 14) load8f(stp + (size_t)(b * 15 + r + 1) * 1024 + c8, f); else unpack8(*(const u32x4*)(UPb + ((size_t)MPR + b) * 1024 + c8), f);
        store8f(out + O_SP + (size_t)l * 1966080 + (b * 15 + r) * 1024 + c8, f); }
    for (size_t i = gtid; i < (size_t)128 * 32; i += gstride) { const int b = (int)(i >> 5), c8 = (int)(i & 31) * 8; const size_t oo = (size_t)l * 4194304 + ((size_t)b * 128 + 127) * 256 + c8;
        unpack8(*(const u32x4*)(Kb + ((size_t)MPR + b) * 256 + c8), f); store8f(out + O_SK + oo, f); unpack8(*(const u32x4*)(Vb + ((size_t)MPR + b) * 256 + c8), f); store8f(out + O_SV + oo, f); }
}

#define XB_TMO      128
#define XB_XCNT(j)  (256  + 64 * (j))
#define XB_XSUB(j)  (1280 + 64 * (j))
#define XB_XGEN(j)  (2304 + 64 * (j))
#define XB_TOP      3328
#define XB_TOPGEN   3392
#define XCD_BAR_WORDS 3456
#define XB_SPIN_CAP (1u << 16)
__device__ __forceinline__ unsigned xb_ld(unsigned* p)              { return __hip_atomic_load(p, __ATOMIC_RELAXED, __HIP_MEMORY_SCOPE_AGENT); }
__device__ __forceinline__ unsigned xb_add(unsigned* p, unsigned v) { return __hip_atomic_fetch_add(p, v, __ATOMIC_RELAXED, __HIP_MEMORY_SCOPE_AGENT); }
__device__ __forceinline__ unsigned xb_xcc_id() { return (unsigned)__builtin_amdgcn_s_getreg((3 << 11) | 20) & 0xFu; }
#define XB_SPIN(cond, bar) do { unsigned _sp = 0; while (cond) { __builtin_amdgcn_s_sleep(8); \
    if ((++_sp & 255u) == 0u) { if (xb_ld(&(bar)[XB_TMO])) break; if (_sp > XB_SPIN_CAP) { atomicAdd(&(bar)[XB_TMO], 1u); break; } } } } while (0)
struct XcdBarrier { unsigned* bar; unsigned x; volatile LAS unsigned* st; };
__device__ __forceinline__ XcdBarrier xcd_barrier_post(unsigned* bar, volatile LAS unsigned* st) {
    XcdBarrier b; b.bar = bar; b.x = xb_xcc_id(); b.st = st;
    if (threadIdx.x == 0) (void)xb_add(&bar[XB_XCNT(b.x)], 1u);
    return b;
}
__device__ __forceinline__ void xcd_barrier_complete(unsigned* bar, unsigned x, unsigned& nloc, unsigned& nx) {
    const unsigned G = gridDim.x * gridDim.y * gridDim.z;
    unsigned sum, cnt, mine, sp = 0u;
    for (;;) {
        sum = 0u; cnt = 0u; mine = 0u;
#pragma unroll
        for (unsigned j = 0; j < 16; ++j) { const unsigned c = xb_ld(&bar[XB_XCNT(j)]); sum += c; cnt += (c > 0u) ? 1u : 0u; mine = (j == x) ? c : mine; }
        if (sum == G) break;
        __builtin_amdgcn_s_sleep(1);
        if ((++sp & 255u) == 0u) { if (xb_ld(&bar[XB_TMO])) break; if (sp > XB_SPIN_CAP) { atomicAdd(&bar[XB_TMO], 1u); break; } }
    }
    nloc = mine > 0u ? mine : 1u; nx = cnt > 0u ? cnt : 1u;
}
__device__ __forceinline__ void xcd_barrier(const XcdBarrier& b) {
    asm volatile("s_waitcnt vmcnt(0)" ::: "memory");
    __syncthreads();
    if (threadIdx.x == 0) {
        unsigned* bar = b.bar;
        __builtin_amdgcn_s_waitcnt(0);
        unsigned nloc = b.st[0], nx = b.st[1];
        if (nloc == 0u) { xcd_barrier_complete(bar, b.x, nloc, nx); b.st[0] = nloc; b.st[1] = nx; }
        const unsigned old = xb_add(&bar[XB_XSUB(b.x)], 1u);
        const unsigned gen = old / nloc;
        if (old + 1u == (gen + 1u) * nloc) {
            __builtin_amdgcn_fence(__ATOMIC_RELEASE, "agent");
            asm volatile("s_waitcnt vmcnt(0)" ::: "memory");
            const unsigned og = xb_add(&bar[XB_TOP], 1u);
            const unsigned tg = og / nx;
            if (og + 1u == (tg + 1u) * nx) xb_add(&bar[XB_TOPGEN], 1u);
            else XB_SPIN(xb_ld(&bar[XB_TOPGEN]) == tg, bar);
            __builtin_amdgcn_fence(__ATOMIC_ACQUIRE, "agent");
            xb_add(&bar[XB_XGEN(b.x)], 1u);
            asm volatile("s_waitcnt vmcnt(0)" ::: "memory");
        } else {
            XB_SPIN(xb_ld(&bar[XB_XGEN(b.x)]) == gen, bar);
            __builtin_amdgcn_fence(__ATOMIC_ACQUIRE, "agent");
            asm volatile("s_waitcnt vmcnt(0)" ::: "memory");
        }
    }
    __syncthreads();
}

#ifndef PHMASK
#define PHMASK 0xFFFF
#endif
#define PH(n) if (PHMASK & (1 << (n)))
#define WSPTRS() PP p = (PP)__builtin_amdgcn_kernarg_segment_ptr(); OPQ_S(p); unsigned char* ws = p->ws; \
    bf16_t* W = (bf16_t*)(ws + WS_W); bf16_t* Hb = (bf16_t*)(ws + WS_H); \
    bf16_t* R1 = (bf16_t*)(ws + WS_R1); bf16_t* R2 = (bf16_t*)(ws + WS_R2); bf16_t* R3 = (bf16_t*)(ws + WS_R3); bf16_t* R4 = (bf16_t*)(ws + WS_R4); \
    bf16_t* Kb = (bf16_t*)(ws + WS_R5); bf16_t* Vb = Kb + (size_t)MP * 256; bf16_t* PLb = (bf16_t*)(ws + WS_R5 + UNIT); \
    bf16_t* MIXf = (bf16_t*)(ws + WS_R2); bf16_t* Ff = (bf16_t*)(ws + WS_R5); bf16_t* X1b = (bf16_t*)(ws + WS_R5 + UNIT); (void)X1b; f32x2* rope = (f32x2*)(ws + WS_ROPE); \
    float* yp = p->out + O_YP; float* ys = p->out + O_YS; \
    (void)W; (void)Hb; (void)R1; (void)R2; (void)R3; (void)R4; (void)Kb; (void)Vb; (void)PLb; (void)MIXf; (void)Ff; (void)rope; (void)yp; (void)ys

__global__ void __launch_bounds__(512, 2) fwd_megakernel(Params p_unused) {
    extern __shared__ __attribute__((aligned(16))) unsigned char shm[];
    LAS unsigned char* lds = (LAS unsigned char*)shm;
    cg::grid_group grid = cg::this_grid();
    volatile LAS unsigned* xb_st = (volatile LAS unsigned*)(lds + STAGE_BYTES);
    if (threadIdx.x == 0) { xb_st[0] = 0u; xb_st[1] = 0u; }
    __syncthreads();
    const XcdBarrier xb = xcd_barrier_post((unsigned*)(((PP)__builtin_amdgcn_kernarg_segment_ptr())->ws + WS_BAR), xb_st);
#define GRID_SYNC() xcd_barrier(xb)
    if (((PP)__builtin_amdgcn_kernarg_segment_ptr())->out == nullptr) grid.sync();
    PH(0) { WSPTRS(); rope_table(rope); }
    PH(1) { WSPTRS(); convert_layer(lds, p, 0, 1, 0); }
    PH(2) { WSPTRS(); float* RS0 = (float*)(ws + WS_RS); row_phase(p->in[0], p->in[1], nullptr, nullptr, nullptr, Hb, nullptr, nullptr, RS0, nullptr, 0, 0, MREAL, 0); }
    GRID_SYNC();

#define STILE(p, ld) ((const char*)((p) + (size_t)MPR * (ld)))
#define SIDEPTRS() bf16_t* GS = (bf16_t*)(ws + WS_GS); bf16_t* MS = (bf16_t*)(ws + WS_MS); float* MIXP = (float*)(ws + WS_MIXP); float* FP = (float*)(ws + WS_FP); float* RS0 = (float*)(ws + WS_RS); float* RS1 = RS0 + MP; (void)GS; (void)MS; (void)MIXP; (void)FP; (void)RS0; (void)RS1
    for (int l = 0; l < 2; ++l) {
        PH(3) { WSPTRS(); SIDEPTRS(); const bf16_t* XA_ = l == 0 ? (const bf16_t*)Hb : (const bf16_t*)yp;     PhaseOrder S; S.init(XA_, W + WO_IN, 1024, 1024, 0, 22, true);
            S.X = Extra{34, 34, STILE(XA_, 1024), (const char*)(W + WO_IN), 0, 0, 0, (size_t)512 * 1024};
            EpiMain E{R1, R2, R3, R4, Kb, Vb, (const f32x4*)rope, GS, RS0}; gemm_phase(lds, 1024, 1024, 1024, S, E);
            convert_layer(lds, p, l, l == 0 ? 6 : 2, 34);
            cache_shift_copy(p->in[4], p->out + O_SK, 34, l * 64, l * 64 + 64); }
        GRID_SYNC();
        PH(4) { WSPTRS(); attn_prompt_all(lds, R4, Kb, Vb, p->in[11] + l * 16, R4); }
        PH(5) { WSPTRS(); for (int it = blockIdx.x; it < 256; it += gridDim.x) attn_sample_item(lds, it, R4, Kb, Vb, p->in[4] + (size_t)l * 128 * 128 * 256, p->in[5] + (size_t)l * 128 * 128 * 256, p->in[11] + l * 16, R4); }
        PH(6) { WSPTRS(); mix_elementwise(p, l, R1, R2, R3, PLb, R2); }
        PH(6) { WSPTRS(); state_outputs(p, l, R1, R3, Kb, Vb); }
        GRID_SYNC();
        PH(7) { WSPTRS(); SIDEPTRS(); const bf16_t* XA_ = l == 0 ? (const bf16_t*)Hb : (const bf16_t*)yp;     PhaseOrder S; S.init(XA_, W + WO_IN + (size_t)5632 * 1024, 1024, 1024, 0, 4, true); EpiAct<0> E{R1, 1024, RS0}; gemm_phase(lds, 1024, 1024, 1024, S, E); }
        PH(8) { WSPTRS(); SIDEPTRS(); PhaseOrder S; S.init(R2, W + WO_CO, 1024, 1024, 0, 4, true);
            S.X = Extra{8, 4, STILE(R2, 1024), (const char*)(W + WO_CO), 2 * UNIT, (WO_AO - WO_CO) * 2, 0, (size_t)512 * 1024};
            EpiGate E{R1, R1, false, GS, MS, 0, 2}; gemm_phase(lds, 1024, 1024, 1024, S, E); }
        PH(7) { WSPTRS(); SIDEPTRS(); const bf16_t* XA_ = l == 0 ? (const bf16_t*)Hb : (const bf16_t*)yp;     PhaseOrder S; S.init(XA_, W + WO_IN + (size_t)7680 * 1024, 1024, 1024, 0, 4, true); EpiAct<0> E{R3, 1024, RS0}; gemm_phase(lds, 1024, 1024, 1024, S, E); }
        PH(10) { WSPTRS(); SIDEPTRS(); PhaseOrder S; S.init(R4, W + WO_AO, 1024, 1024, 0, 4, true); EpiGate E{R1, R3, true, GS, MS, 0, 0}; gemm_phase(lds, 1024, 1024, 1024, S, E);
            cache_shift_copy(p->in[5] + (size_t)l * 128 * 128 * 256, p->out + O_SV + (size_t)l * 4194304, 8); }
        PH(7) { WSPTRS(); SIDEPTRS(); const bf16_t* XA_ = l == 0 ? (const bf16_t*)Hb : (const bf16_t*)yp;     PhaseOrder S; S.init(XA_, W + WO_IN + (size_t)6656 * 1024, 1024, 1024, 0, 4, true); EpiAct<0> E{Kb, 1024, RS0};     gemm_phase(lds, 1024, 1024, 1024, S, E); }
        PH(9) { WSPTRS(); SIDEPTRS(); PhaseOrder S; S.init(PLb, W + WO_POOL, 1024, 256, 256, 4, true);
            S.X = Extra{4, 4, STILE(PLb, 1024), (const char*)(W + WO_POOL), 0, 0, 512, (size_t)512 * 256};
            EpiGate E{R1, Kb, true, GS, MS, 1, 1}; int kpool = 256; OPQ_S(kpool); gemm_phase(lds, kpool, 1024, 256, S, E); }
        GRID_SYNC();
        PH(11) { WSPTRS(); SIDEPTRS(); PhaseOrder S; S.init(R1, W + WO_MIX, 1024, 1024, 0, 4, true); EpiOut E{MIXf, MIXP}; gemm_phase(lds, 1024, 1024, 1024, S, E); }
        GRID_SYNC();
        PH(11) { WSPTRS(); SIDEPTRS(); PhaseOrder S; S.init(R1, W + WO_MIX, 1024, 1024, 0, 4, false);
            S.X = Extra{12, 4, (const char*)MS, (const char*)(W + WO_MIX), SIDE * 2, 0, 0, (size_t)512 * 1024};
            EpiOut E{MIXf, MIXP}; gemm_phase(lds, 1024, 1024, 1024, S, E); }
        PH(12) { WSPTRS(); SIDEPTRS(); const bf16_t* XA_ = l == 0 ? (const bf16_t*)Hb : (const bf16_t*)yp;     row_phase(nullptr, nullptr, XA_, nullptr, nullptr, X1b, MIXf, p->in[15] + l * 1024, RS1, MIXP, 3, 0, MPR, 12); }
        GRID_SYNC();
        PH(12) { WSPTRS(); SIDEPTRS(); const bf16_t* XA_ = l == 0 ? (const bf16_t*)Hb : (const bf16_t*)yp;     row_phase(nullptr, nullptr, XA_, nullptr, nullptr, X1b, MIXf, p->in[15] + l * 1024, RS1, MIXP, 3, MPR, MREAL, 0); }
        GRID_SYNC();
        PH(13) { WSPTRS(); SIDEPTRS(); PhaseOrder S; S.init(X1b, W + WO_UP, 1024, 1024, 0, 16, true);
            S.X = Extra{16, 16, STILE(X1b, 1024), (const char*)(W + WO_UP), 0, 0, 0, (size_t)512 * 1024};
            EpiAct<1> E{R1, DFF, RS1}; gemm_phase(lds, 1024, 1024, 1024, S, E);
            if (l == 0) convert_layer(lds, p, 1, 5, 16); else cache_shift_copy(p->in[4] + (size_t)128 * 128 * 256, p->out + O_SK + (size_t)4194304, 16); }
        GRID_SYNC();
        PH(14) { WSPTRS(); SIDEPTRS(); PhaseOrder S; S.init(R1, W + WO_DN, DFF, DFF, 0, 4, true); EpiOut E{Ff, FP}; gemm_phase(lds, DFF, DFF, DFF, S, E); }
        GRID_SYNC();
        PH(14) { WSPTRS(); SIDEPTRS(); PhaseOrder S; S.init(R1, W + WO_DN, DFF, DFF, 0, 4, false);
            S.X = Extra{16, 4, STILE(R1, DFF), (const char*)(W + WO_DN), 2048, 2048, 0, (size_t)512 * DFF};
            EpiOut E{Ff, FP}; gemm_phase(lds, 1024, DFF, DFF, S, E); }
        PH(12) { WSPTRS(); SIDEPTRS(); row_phase(nullptr, nullptr, X1b, l == 0 ? nullptr : yp, l == 0 ? nullptr : ys, l == 0 ? (bf16_t*)yp : nullptr, Ff, p->in[17] + l * 1024, l == 0 ? RS0 : nullptr, FP, 4, 0, MPR, 16); }
        GRID_SYNC();
        PH(12) { WSPTRS(); SIDEPTRS(); row_phase(nullptr, nullptr, X1b, l == 0 ? nullptr : yp, l == 0 ? nullptr : ys, l == 0 ? (bf16_t*)yp : nullptr, Ff, p->in[17] + l * 1024, l == 0 ? RS0 : nullptr, FP, 4, MPR, MREAL, 0); }
        if (l == 0) GRID_SYNC();
    }
}

extern "C" void kernel_launch(void* const* d_in, const int* in_sizes, int n_in, void* d_out, int out_size, void* d_ws, size_t ws_size, hipStream_t stream) {
    constexpr size_t kDynLds = STAGE_BYTES + 64;
    static int grid_blocks = 0;
    if (!grid_blocks) {
        int dev = 0, cus = 0, per_cu = 0;
        hipGetDevice(&dev);
        hipDeviceGetAttribute(&cus, hipDeviceAttributeMultiprocessorCount, dev);
        hipFuncSetAttribute((const void*)fwd_megakernel, hipFuncAttributeMaxDynamicSharedMemorySize, (int)kDynLds);
        hipOccupancyMaxActiveBlocksPerMultiprocessor(&per_cu, (const void*)fwd_megakernel, 512, kDynLds);
        if (per_cu < 1) per_cu = 1;
        grid_blocks = cus * per_cu;
        if (ws_size < WS_END) fprintf(stderr, "kernel_launch: workspace too small: %zu < %zu\n", ws_size, (size_t)WS_END);
    }
    Params p{};
    for (int i = 0; i < 20; ++i) p.in[i] = (const float*)d_in[i];
    p.out = (float*)d_out; p.ws = (unsigned char*)d_ws;
    (void)hipMemsetAsync((char*)d_ws + WS_BAR, 0, 16384, stream);
    void* args[] = {&p};
    hipError_t e = hipLaunchCooperativeKernel((const void*)fwd_megakernel, dim3(grid_blocks), dim3(512), args, kDynLds, stream);
    if (e != hipSuccess) fprintf(stderr, "cooperative launch failed: %s (grid %d)\n", hipGetErrorString(e), grid_blocks);
}
```
